# Optimizing an MI355X kernel written in HIP

```python
import math
import jax, jax.numpy as jnp
from jax import lax
import numpy as np

D_MODEL = 1024
BATCH = 8
SEQ = 4096
DEPTH = 1

N_META = 16
BLOCK_Q = 128
HEAD_DIM = 64
N_HEADS_DIFF = 8
DIFF_V_DIM = 2 * HEAD_DIM
D_QK_DIFF = 2 * N_HEADS_DIFF * HEAD_DIM
D_DIFF = N_HEADS_DIFF * DIFF_V_DIM
N_HEADS_SB = 16
D_SB = N_HEADS_SB * HEAD_DIM
D_FF = 4 * D_MODEL
ROPE_THETA = 10000.0
EPS = 1e-6
IN_SIZES = [D_QK_DIFF, D_QK_DIFF, D_DIFF, D_SB, D_SB, D_SB, D_MODEL, D_MODEL]
D_IN = sum(IN_SIZES)

kernel_name = "hybrid_diffattn_stickbreaking_gated"


def lambda_init_fn(layer_idx):
    return 0.8 - 0.6 * math.exp(-0.3 * layer_idx)


def rmsnorm(x, g):
    xf = x.astype(jnp.float32)
    y = xf * lax.rsqrt(jnp.mean(xf * xf, axis=-1, keepdims=True) + EPS)
    return (y * g.astype(jnp.float32)).astype(x.dtype)


def rope(x, pos):
    d = x.shape[-1]
    inv = ROPE_THETA ** (-jnp.arange(0, d, 2, dtype=jnp.float32) / d)
    ang = pos.astype(jnp.float32)[:, None] * inv[None, :]
    cos, sin = jnp.cos(ang), jnp.sin(ang)
    xf = x.astype(jnp.float32)
    x1, x2 = xf[..., : d // 2], xf[..., d // 2:]
    out = jnp.concatenate([x1 * cos - x2 * sin, x2 * cos + x1 * sin], axis=-1)
    return out.astype(x.dtype)


def block_bounds():
    bounds = [(0, N_META)]
    for s in range(0, SEQ, BLOCK_Q):
        bounds.append((N_META + s, N_META + min(SEQ, s + BLOCK_Q)))
    return bounds


def diff_attn_block(qa, ka, va, lam, start, end):
    B = qa.shape[0]
    tq = end - start
    s = jnp.einsum('bhqd,bhkd->bhqk', qa[:, :, start:end], ka[:, :, :end]).astype(jnp.float32)
    s = s / math.sqrt(HEAD_DIM)
    causal = jnp.arange(start, end)[:, None] >= jnp.arange(end)[None, :]
    p = jax.nn.softmax(jnp.where(causal, s, -jnp.inf), axis=-1)
    p = p.reshape(B, N_HEADS_DIFF, 2, tq, end)
    a = p[:, :, 0] - lam * p[:, :, 1]
    return jnp.einsum('bhqk,bhkd->bhqd', a.astype(va.dtype), va[:, :, :end])


def stick_breaking_block(qb, kb, vb, start, end):
    z = jnp.einsum('bhqd,bhkd->bhqk', qb[:, :, start:end], kb[:, :, :end]).astype(jnp.float32)
    z = z / math.sqrt(HEAD_DIM)
    strict = jnp.arange(end)[None, :] < jnp.arange(start, end)[:, None]
    log_1m = jnp.where(strict, jax.nn.log_sigmoid(-z), 0.0)
    rcum = lax.cumsum(log_1m, axis=3, reverse=True)
    excl = jnp.concatenate([rcum[..., 1:], jnp.zeros_like(rcum[..., :1])], axis=-1)
    log_a = jax.nn.log_sigmoid(z) + excl
    a = jnp.where(strict, jnp.exp(log_a), 0.0)
    return jnp.einsum('bhqk,bhkd->bhqd', a.astype(vb.dtype), vb[:, :, :end])


def setup_inputs(seed: int = 0) -> dict:
    key = jax.random.key(seed)
    ks = jax.random.split(key, 16)
    nrm = jax.random.normal
    f32 = jnp.float32
    return {
        "x": nrm(ks[0], (BATCH, SEQ, D_MODEL), f32),
        "meta_tokens": nrm(ks[1], (N_META, D_MODEL), f32),
        "norm_mix_g": 1.0 + 0.02 * nrm(ks[2], (DEPTH, D_MODEL), f32),
        "w_in": nrm(ks[3], (DEPTH, D_MODEL, D_IN), f32) * D_MODEL ** -0.5,
        "lambda_q1": 0.1 * nrm(ks[4], (DEPTH, HEAD_DIM), f32),
        "lambda_k1": 0.1 * nrm(ks[5], (DEPTH, HEAD_DIM), f32),
        "lambda_q2": 0.1 * nrm(ks[6], (DEPTH, HEAD_DIM), f32),
        "lambda_k2": 0.1 * nrm(ks[7], (DEPTH, HEAD_DIM), f32),
        "subln_g": 1.0 + 0.02 * nrm(ks[8], (DEPTH, DIFF_V_DIM), f32),
        "w_out_a": nrm(ks[9], (DEPTH, D_DIFF, D_MODEL), f32) * D_DIFF ** -0.5,
        "w_out_b": nrm(ks[10], (DEPTH, D_SB, D_MODEL), f32) * D_SB ** -0.5,
        "w_out": nrm(ks[11], (DEPTH, D_MODEL, D_MODEL), f32) * D_MODEL ** -0.5,
        "norm_mlp_g": 1.0 + 0.02 * nrm(ks[12], (DEPTH, D_MODEL), f32),
        "w_up": nrm(ks[13], (DEPTH, D_MODEL, D_FF), f32) * D_MODEL ** -0.5,
        "w_down": nrm(ks[14], (DEPTH, D_FF, D_MODEL), f32) * D_FF ** -0.5,
        "norm_final_g": 1.0 + 0.02 * nrm(ks[15], (D_MODEL,), f32),
    }


def reference(x, meta_tokens, norm_mix_g, w_in, lambda_q1, lambda_k1, lambda_q2, lambda_k2,
              subln_g, w_out_a, w_out_b, w_out, norm_mlp_g, w_up, w_down, norm_final_g):
    B = x.shape[0]
    meta = jnp.broadcast_to(meta_tokens.astype(x.dtype)[None], (B, N_META, D_MODEL))
    h = jnp.concatenate([meta, x], axis=1)
    L = h.shape[1]
    pos = jnp.arange(L, dtype=jnp.int32)
    split_idx = list(np.cumsum(IN_SIZES)[:-1])
    bounds = block_bounds()

    for layer in range(DEPTH):
        lam_init = lambda_init_fn(layer)
        hn = rmsnorm(h, norm_mix_g[layer])
        proj = hn @ w_in[layer]
        qa, ka, va, qb, kb, vb, ga, gb = jnp.split(proj, split_idx, axis=-1)
        qa = rope(qa.reshape(B, L, 2 * N_HEADS_DIFF, HEAD_DIM).transpose(0, 2, 1, 3), pos)
        ka = rope(ka.reshape(B, L, 2 * N_HEADS_DIFF, HEAD_DIM).transpose(0, 2, 1, 3), pos)
        va = va.reshape(B, L, N_HEADS_DIFF, DIFF_V_DIM).transpose(0, 2, 1, 3)
        qb = qb.reshape(B, L, N_HEADS_SB, HEAD_DIM).transpose(0, 2, 1, 3)
        kb = kb.reshape(B, L, N_HEADS_SB, HEAD_DIM).transpose(0, 2, 1, 3)
        vb = vb.reshape(B, L, N_HEADS_SB, HEAD_DIM).transpose(0, 2, 1, 3)
        lam = (jnp.exp(jnp.sum(lambda_q1[layer].astype(jnp.float32) * lambda_k1[layer].astype(jnp.float32)))
               - jnp.exp(jnp.sum(lambda_q2[layer].astype(jnp.float32) * lambda_k2[layer].astype(jnp.float32)))
               + lam_init)

        outs_a, outs_b = [], []
        for (s0, e0) in bounds:
            outs_a.append(diff_attn_block(qa, ka, va, lam, s0, e0))
            outs_b.append(stick_breaking_block(qb, kb, vb, s0, e0))
        oa = jnp.concatenate(outs_a, axis=2)
        ob = jnp.concatenate(outs_b, axis=2)
        oa = rmsnorm(oa, subln_g[layer]) * (1.0 - lam_init)
        oa = oa.transpose(0, 2, 1, 3).reshape(B, L, D_DIFF)
        ob = ob.transpose(0, 2, 1, 3).reshape(B, L, D_SB)
        ua = oa @ w_out_a[layer]
        ub = ob @ w_out_b[layer]
        merged = jax.nn.sigmoid(ga) * ua + jax.nn.sigmoid(gb) * ub
        h = h + merged @ w_out[layer]
        hm = rmsnorm(h, norm_mlp_g[layer])
        h = h + jnp.square(jax.nn.relu(hm @ w_up[layer])) @ w_down[layer]

    h = rmsnorm(h, norm_final_g)
    return h[:, N_META:]
```

```cpp
#include <hip/hip_runtime.h>
#include <hip/hip_cooperative_groups.h>
#include <cstdio>
#include <cstdint>
namespace cg = cooperative_groups;
#ifndef PROBE_DIFF
#define PROBE_DIFF 0
#endif
#ifndef PROBE_SB
#define PROBE_SB 0
#endif
#ifndef PROBE_P1
#define PROBE_P1 0
#endif
#ifndef MK_MULTI
#define MK_MULTI 0
#endif
namespace pg8 {
#define PG8_LAS __attribute__((address_space(3)))
typedef unsigned short bf16_t;
typedef short bf16x8 __attribute__((ext_vector_type(8)));
typedef float f32x4 __attribute__((ext_vector_type(4)));
typedef unsigned u32x4 __attribute__((ext_vector_type(4)));
constexpr int BM = 256, BK = 64, HALF = 128, HTB = HALF * BK * 2  , STAGE_BYTES = 8 * HTB, NXCD = 8, WGM = 8;

__host__ __device__ __forceinline__ int lds_byte(int r, int c) { const int st = (r >> 4) * 2 + (c >> 5), rr = r & 15, cc = c & 31, ob = rr * 64 + cc * 2; return st * 1024 + (ob ^ (((ob >> 9) & 1) << 5)); }
__host__ __device__ __forceinline__ void stage_rc(int b, int& R, int& C) { const int st = b / 1024, sb = b % 1024, swz = sb ^ (((sb >> 9) & 1) << 5); R = (st >> 1) * 16 + swz / 64; C = (st & 1) * 32 + (swz % 64) / 2; }
__host__ __device__ __forceinline__ int perm32(int rho) { const int n = rho >> 4, i = rho & 15; return 8 * (i >> 2) + 4 * n + (i & 3); }

struct Unit { int pm, pn; };
struct Gemm { const bf16_t* A; const bf16_t* Bt; int M, N, K; int skip;
    __device__ __forceinline__ const char* a_ptr(int pm) const { return (const char*)A + ((size_t)pm * 256 + (skip ? 16 * ((pm >> 4) + 1) : 0)) * (size_t)K * 2; } };

struct StaticOrder {
    int nM, nN, nwg, G, c;
    __host__ __device__ void init(int M, int N, int G_, int c_) { nM = M / BM; nN = N / BM; nwg = nM * nN; G = G_; c = c_; }
    __host__ __device__ bool next(int i, Unit& u) const {
        const long L = (long)i * G + c; if (L >= nwg) return false;
        int wgid = (int)L; { const int q = nwg / NXCD, r = nwg % NXCD, xcd = wgid % NXCD, off = wgid / NXCD; wgid = (xcd < r ? xcd * (q + 1) : r * (q + 1) + (xcd - r) * q) + off; }
        const int nig = WGM * nN, gid = wgid / nig, fm = gid * WGM, gsz = (nM - fm) < WGM ? (nM - fm) : WGM;
        u.pm = fm + ((wgid % nig) % gsz); u.pn = (wgid % nig) / gsz; return true;
    }
    __device__ __forceinline__ void a_ready(const Unit&) const {}
    __device__ __forceinline__ void done(const Unit&) const {}
};

typedef float f32x2 __attribute__((ext_vector_type(2))); typedef __bf16 bf16x2_t_ __attribute__((ext_vector_type(2)));
__device__ __forceinline__ unsigned cvt_pk_bf16(float lo, float hi) { f32x2 v = {lo, hi}; bf16x2_t_ b = __builtin_convertvector(v, bf16x2_t_); return __builtin_bit_cast(unsigned, b); }

typedef unsigned u32x4 __attribute__((ext_vector_type(4)));
__device__ __forceinline__ float bf_lo(unsigned w) { return __uint_as_float(w << 16); }
__device__ __forceinline__ float bf_hi(unsigned w) { return __uint_as_float(w & 0xffff0000u); }
__device__ __forceinline__ u32x4 pack8(const f32x4& a, const f32x4& b) { u32x4 w; w.x = cvt_pk_bf16(a[0], a[1]); w.y = cvt_pk_bf16(a[2], a[3]); w.z = cvt_pk_bf16(b[0], b[1]); w.w = cvt_pk_bf16(b[2], b[3]); return w; }
__device__ __forceinline__ float sigmoidf_(float x) { return __builtin_amdgcn_rcpf(1.0f + __builtin_amdgcn_exp2f(x * -1.4426950408889634f)); }
constexpr int E_L = 4112, E_MFLAT = 8 * 4112, E_MQ = 8 * 4096;

constexpr int EPI_STG_OFF = 131072 + 1024, EPI_STG_WAVE = 16 * 144;
__device__ __forceinline__ void store_rows16(PG8_LAS unsigned char* stg, bf16_t* gbase, size_t ld, int fr, int fq, const u32x4& w0, const u32x4& w1) {
    *(PG8_LAS u32x4*)(stg + fr * 144 + fq * 16) = w0; *(PG8_LAS u32x4*)(stg + fr * 144 + 64 + fq * 16) = w1;
    const int lane = fr + 16 * fq;
#pragma unroll
    for (int j = 0; j < 2; ++j) { const int c = lane + 64 * j, row = c >> 3, ch = c & 7; const u32x4 v = *(const PG8_LAS u32x4*)(stg + row * 144 + ch * 16); *(u32x4*)(gbase + (size_t)row * ld + ch * 8) = v; }
}
struct EpiProj {
    static constexpr bool PERM = true, AFTER_DRAIN = false;
    bf16_t* P; size_t sec_stride; bf16_t* G; const float* rope; PG8_LAS unsigned char* stg;
    __device__ __forceinline__ void operator()(const f32x4 (&acc)[2][2][4][2], const Unit& u, int wr, int wc, int fr, int fq) const {
        const int sec = u.pn >> 2, colt = (u.pn & 3) * 256;
        const int row0 = u.pm * BM + wr * 64 + fr, col0 = colt + wc * 64 + 8 * fq, colw = colt + wc * 64; PG8_LAS unsigned char* st = stg + (wr * 4 + wc) * EPI_STG_WAVE;
        if (sec < 2) {
            const float sc = sec == 0 ? 0.125f : 1.0f;
#pragma unroll
            for (int ai = 0; ai < 2; ++ai) {
                f32x4 c0[4][2], c1[4][2];
#pragma unroll
                for (int m = 0; m < 4; ++m) { const int Rq = row0 + ai * HALF + m * 16; const int t = (Rq & 4095) + 16;
#pragma unroll
                    for (int bj = 0; bj < 2; ++bj) { const f32x4* rp = (const f32x4*)(rope + ((size_t)t * 32 + 16 * bj + 4 * fq) * 2); c0[m][bj] = rp[0]; c1[m][bj] = rp[1]; } }
#pragma unroll
                for (int m = 0; m < 4; ++m) { const int Rq = row0 + ai * HALF + m * 16; const int R = Rq + 16 * ((Rq >> 12) + 1);
                    u32x4 wv[2];
#pragma unroll
                    for (int bj = 0; bj < 2; ++bj) { const f32x4 v0 = acc[ai][bj][m][0], v1 = acc[ai][bj][m][1]; f32x4 o0, o1;
                        o0[0] = (v0[0] * c0[m][bj][0] - v0[1] * c0[m][bj][1]) * sc; o0[1] = (v0[1] * c0[m][bj][0] + v0[0] * c0[m][bj][1]) * sc;
                        o0[2] = (v0[2] * c0[m][bj][2] - v0[3] * c0[m][bj][3]) * sc; o0[3] = (v0[3] * c0[m][bj][2] + v0[2] * c0[m][bj][3]) * sc;
                        o1[0] = (v1[0] * c1[m][bj][0] - v1[1] * c1[m][bj][1]) * sc; o1[1] = (v1[1] * c1[m][bj][0] + v1[0] * c1[m][bj][1]) * sc;
                        o1[2] = (v1[2] * c1[m][bj][2] - v1[3] * c1[m][bj][3]) * sc; o1[3] = (v1[3] * c1[m][bj][2] + v1[2] * c1[m][bj][3]) * sc;
                        wv[bj] = pack8(o0, o1); }
                    store_rows16(st, P + (size_t)sec * sec_stride + (size_t)(R - fr) * 1024 + colw, 1024, fr, fq, wv[0], wv[1]); }
            }
        } else if (sec < 6) {
            const float sc = sec == 3 ? 0.125f * 1.4426950408889634f : 1.0f;
#pragma unroll
            for (int ai = 0; ai < 2; ++ai)
#pragma unroll
                for (int m = 0; m < 4; ++m) { const int Rq = row0 + ai * HALF + m * 16; const int R = Rq + 16 * ((Rq >> 12) + 1);
                    u32x4 wv[2];
#pragma unroll
                    for (int bj = 0; bj < 2; ++bj) { const f32x4 v0 = acc[ai][bj][m][0] * sc, v1 = acc[ai][bj][m][1] * sc; wv[bj] = pack8(v0, v1); }
                    store_rows16(st, P + (size_t)sec * sec_stride + (size_t)(R - fr) * 1024 + colw, 1024, fr, fq, wv[0], wv[1]); }
        } else {
#pragma unroll
            for (int ai = 0; ai < 2; ++ai)
#pragma unroll
                for (int m = 0; m < 4; ++m) { const int Rq = row0 + ai * HALF + m * 16;
                    u32x4 wv[2];
#pragma unroll
                    for (int bj = 0; bj < 2; ++bj) { const f32x4 v0 = acc[ai][bj][m][0], v1 = acc[ai][bj][m][1]; f32x4 o0, o1;
#pragma unroll
                        for (int e = 0; e < 4; ++e) { o0[e] = sigmoidf_(v0[e]); o1[e] = sigmoidf_(v1[e]); }
                        wv[bj] = pack8(o0, o1); }
                    store_rows16(st, G + (size_t)(sec - 6) * ((size_t)E_MQ * 1024) + (size_t)(Rq - fr) * 1024 + colw, 1024, fr, fq, wv[0], wv[1]); }
        }
    }
};
template <int WHICH> struct EpiGate {
    static constexpr bool PERM = true, AFTER_DRAIN = false;
    const bf16_t* G; bf16_t* T; bf16_t* O; PG8_LAS unsigned char* stg;
    __device__ __forceinline__ void operator()(const f32x4 (&acc)[2][2][4][2], const Unit& u, int wr, int wc, int fr, int fq) const {
        const int row0 = u.pm * BM + wr * 64 + fr, col0 = u.pn * BM + wc * 64 + 8 * fq;
#pragma unroll
        for (int ai = 0; ai < 2; ++ai) {
            u32x4 gv[4][2], tv[4][2];
#pragma unroll
            for (int m = 0; m < 4; ++m) { const size_t off = (size_t)(row0 + ai * HALF + m * 16) * 1024 + col0;
#pragma unroll
                for (int bj = 0; bj < 2; ++bj) { gv[m][bj] = *(const u32x4*)(G + off + bj * 32); if (WHICH == 1) tv[m][bj] = *(const u32x4*)(T + off + bj * 32); } }
#pragma unroll
            for (int m = 0; m < 4; ++m) { const size_t off = (size_t)(row0 + ai * HALF + m * 16) * 1024 + col0;
                u32x4 wv[2];
#pragma unroll
                for (int bj = 0; bj < 2; ++bj) { const u32x4 g = gv[m][bj]; const f32x4 v0 = acc[ai][bj][m][0], v1 = acc[ai][bj][m][1]; f32x4 o0, o1;
                    o0[0] = v0[0] * bf_lo(g.x); o0[1] = v0[1] * bf_hi(g.x); o0[2] = v0[2] * bf_lo(g.y); o0[3] = v0[3] * bf_hi(g.y);
                    o1[0] = v1[0] * bf_lo(g.z); o1[1] = v1[1] * bf_hi(g.z); o1[2] = v1[2] * bf_lo(g.w); o1[3] = v1[3] * bf_hi(g.w);
                    if (WHICH == 1) { const u32x4 t = tv[m][bj];
                        o0[0] += bf_lo(t.x); o0[1] += bf_hi(t.x); o0[2] += bf_lo(t.y); o0[3] += bf_hi(t.y);
                        o1[0] += bf_lo(t.z); o1[1] += bf_hi(t.z); o1[2] += bf_lo(t.w); o1[3] += bf_hi(t.w); }
                    wv[bj] = pack8(o0, o1); }
                store_rows16(stg + (wr * 4 + wc) * EPI_STG_WAVE, (WHICH == 0 ? T : O) + off - (size_t)fr * 1024 - 8 * fq, 1024, fr, fq, wv[0], wv[1]); }
        }
    }
};
struct EpiOut {
    static constexpr bool PERM = true, AFTER_DRAIN = false;
    const float* x; float* h2; bf16_t* h2b; float* ss; PG8_LAS unsigned char* stg;
    __device__ __forceinline__ void operator()(const f32x4 (&acc)[2][2][4][2], const Unit& u, int wr, int wc, int fr, int fq) const {
        const int row0 = u.pm * BM + wr * 64 + fr, col0 = u.pn * BM + wc * 64 + 8 * fq;
#pragma unroll
        for (int ai = 0; ai < 2; ++ai) {
            f32x4 xa[4][2], xb[4][2];
#pragma unroll
            for (int m = 0; m < 4; ++m) { const size_t off = (size_t)(row0 + ai * HALF + m * 16) * 1024 + col0;
#pragma unroll
                for (int bj = 0; bj < 2; ++bj) { xa[m][bj] = *(const f32x4*)(x + off + bj * 32); xb[m][bj] = *(const f32x4*)(x + off + bj * 32 + 4); } }
#pragma unroll
            for (int m = 0; m < 4; ++m) { const int R = row0 + ai * HALF + m * 16; const size_t off = (size_t)R * 1024 + col0; float q = 0.f;
                u32x4 wv[2];
#pragma unroll
                for (int bj = 0; bj < 2; ++bj) { const f32x4 o0 = xa[m][bj] + acc[ai][bj][m][0], o1 = xb[m][bj] + acc[ai][bj][m][1];
                    wv[bj] = pack8(o0, o1);
                    q += (o0[0] * o0[0] + o0[1] * o0[1]) + (o0[2] * o0[2] + o0[3] * o0[3]) + (o1[0] * o1[0] + o1[1] * o1[1]) + (o1[2] * o1[2] + o1[3] * o1[3]); }
                store_rows16(stg + (wr * 4 + wc) * EPI_STG_WAVE, h2b + off - (size_t)fr * 1024 - 8 * fq, 1024, fr, fq, wv[0], wv[1]);
                q += __shfl_xor(q, 16); q += __shfl_xor(q, 32);
                if (fq == 0) ss[(size_t)R * 16 + u.pn * 4 + wc] = q; }
        }
    }
};
struct EpiUp {
    static constexpr bool PERM = true, AFTER_DRAIN = false;
    const float* ss; bf16_t* U; PG8_LAS unsigned char* stg;
    __device__ __forceinline__ void operator()(const f32x4 (&acc)[2][2][4][2], const Unit& u, int wr, int wc, int fr, int fq) const {
        const int row0 = u.pm * BM + wr * 64 + fr, col0 = u.pn * BM + wc * 64 + 8 * fq;
#pragma unroll
        for (int ai = 0; ai < 2; ++ai)
#pragma unroll
            for (int m = 0; m < 4; ++m) { const int R = row0 + ai * HALF + m * 16;
                u32x4 wv[2];
#pragma unroll
                for (int bj = 0; bj < 2; ++bj) { f32x4 v0 = acc[ai][bj][m][0], v1 = acc[ai][bj][m][1];
#pragma unroll
                    for (int e = 0; e < 4; ++e) { const float a = fmaxf(v0[e], 0.f), b = fmaxf(v1[e], 0.f); v0[e] = a * a; v1[e] = b * b; }
                    wv[bj] = pack8(v0, v1); }
                store_rows16(stg + (wr * 4 + wc) * EPI_STG_WAVE, U + (size_t)(R - fr) * 4096 + col0 - 8 * fq, 4096, fr, fq, wv[0], wv[1]); }
    }
};
struct EpiDown {
    static constexpr bool PERM = true, AFTER_DRAIN = false;
    const bf16_t* h2b; bf16_t* h; PG8_LAS unsigned char* stg; const float* r2a;
    __device__ __forceinline__ void operator()(const f32x4 (&acc)[2][2][4][2], const Unit& u, int wr, int wc, int fr, int fq) const {
        const int row0 = u.pm * BM + wr * 64 + fr, col0 = u.pn * BM + wc * 64 + 8 * fq;
#pragma unroll
        for (int ai = 0; ai < 2; ++ai) {
            u32x4 rv[4][2]; float r2v[4];
#pragma unroll
            for (int m = 0; m < 4; ++m) { const int R = row0 + ai * HALF + m * 16; const size_t off = (size_t)R * 1024 + col0; r2v[m] = r2a[R];
#pragma unroll
                for (int bj = 0; bj < 2; ++bj) rv[m][bj] = *(const u32x4*)(h2b + off + bj * 32); }
#pragma unroll
            for (int m = 0; m < 4; ++m) { const size_t off = (size_t)(row0 + ai * HALF + m * 16) * 1024 + col0; const float r2 = r2v[m];
                u32x4 wv[2];
#pragma unroll
                for (int bj = 0; bj < 2; ++bj) { const u32x4 r = rv[m][bj];
                    const f32x4 a = {bf_lo(r.x), bf_hi(r.x), bf_lo(r.y), bf_hi(r.y)}, b = {bf_lo(r.z), bf_hi(r.z), bf_lo(r.w), bf_hi(r.w)};
                    wv[bj] = pack8(a + acc[ai][bj][m][0] * r2, b + acc[ai][bj][m][1] * r2); }
                store_rows16(stg + (wr * 4 + wc) * EPI_STG_WAVE, h + off - (size_t)fr * 1024 - 8 * fq, 1024, fr, fq, wv[0], wv[1]); }
        }
    }
};

template <class Epi, class Sched, bool ALIGN_EPI = false, bool SP2 = false>
__device__ __forceinline__ void gemm_phase(PG8_LAS unsigned char* lds, const Gemm g, const Sched& S, const Epi& E) {
    const int tid = threadIdx.x, wid = __builtin_amdgcn_readfirstlane(tid >> 6), lane = tid & 63, wr = wid >> 2, wc = wid & 3, fr = lane & 15, fq = lane >> 4;
    const int K = g.K, nt = K / BK;
    unsigned voffA[2], voffB[2];
#pragma unroll
    for (int i = 0; i < 2; ++i) { int R, C; stage_rc(tid * 16 + i * 8192, R, C); const int Rb = Epi::PERM ? (64 * (R >> 5) + perm32(R & 31)) : R;
        voffA[i] = (unsigned)(R * K + C) * 2u; voffB[i] = (unsigned)(Rb * K + C) * 2u; }
    const size_t kstep = (size_t)(BK * 2);
    const size_t hstep = (size_t)HALF * K * 2;
    const size_t tstep = 2 * hstep;
    const size_t hstepB = Epi::PERM ? (size_t)32 * K * 2 : hstep;
    const unsigned ldsw = (unsigned)wid * 1024u;
    const int aoff = lds_byte(wr * 64 + fr, fq * 8), boff = lds_byte(wc * 32 + fr, fq * 8);
#define PG8_SA(b, h) (((b) * 2 + (h)) * HTB)
#define PG8_SB(b, h) ((4 + (b) * 2 + (h)) * HTB)
#define PG8_STAGE(bufoff, gbase, voff) do { _Pragma("unroll") for (int _i = 0; _i < 2; ++_i) \
        __builtin_amdgcn_global_load_lds((const unsigned*)((const char*)(gbase) + (voff)[_i]), (PG8_LAS unsigned*)(lds + (bufoff) + ldsw + _i * 8192), 16, 0, 0); } while (0)
#define PG8_LDA(dst, b, h) do { _Pragma("unroll") for (int m = 0; m < 4; ++m) _Pragma("unroll") for (int k = 0; k < 2; ++k) dst[m][k] = *(const PG8_LAS bf16x8*)(lds + PG8_SA(b, h) + aoff + m * 2048 + k * 1024); } while (0)
#define PG8_LDB(dst, b, h) do { _Pragma("unroll") for (int n = 0; n < 2; ++n) _Pragma("unroll") for (int k = 0; k < 2; ++k) dst[n][k] = *(const PG8_LAS bf16x8*)(lds + PG8_SB(b, h) + boff + n * 2048 + k * 1024); } while (0)
#define PG8_MMA(ai, bj, At, Bt) do { __builtin_amdgcn_s_setprio(1); _Pragma("unroll") for (int m = 0; m < 4; ++m) _Pragma("unroll") for (int n = 0; n < 2; ++n) _Pragma("unroll") for (int k = 0; k < 2; ++k) \
        acc[ai][bj][m][n] = __builtin_amdgcn_mfma_f32_16x16x32_bf16(Bt[n][k], At[m][k], acc[ai][bj][m][n], 0, 0, 0); __builtin_amdgcn_s_setprio(0); } while (0)
#define PG8_WAIT_V(n) asm volatile("s_waitcnt vmcnt(" #n ")" ::: "memory")
#define PG8_WAIT_L(n) asm volatile("s_waitcnt lgkmcnt(" #n ")" ::: "memory")
#define PG8_BAR __builtin_amdgcn_s_barrier()
#define PG8_SCHED __builtin_amdgcn_sched_barrier(0)
    Unit cur, nxt; int ui = 0;
    if (!S.next(0, cur)) return;
    f32x4 acc[2][2][4][2];
#pragma unroll
    for (int a = 0; a < 2; ++a)
#pragma unroll
        for (int b = 0; b < 2; ++b)
#pragma unroll
            for (int m = 0; m < 4; ++m)
#pragma unroll
                for (int n = 0; n < 2; ++n) acc[a][b][m][n] = (f32x4){0.f, 0.f, 0.f, 0.f};
    bf16x8 At[4][2], B0[2][2], B1[2][2];
    const char* cA = g.a_ptr(cur.pm); const char* cB = (const char*)g.Bt + (size_t)cur.pn * tstep;
    S.a_ready(cur);
    if constexpr (SP2) {
        PG8_STAGE(PG8_SB(0, 0), cB, voffB); PG8_STAGE(PG8_SB(0, 1), cB + hstepB, voffB); PG8_STAGE(PG8_SA(0, 0), cA, voffA); PG8_STAGE(PG8_SA(0, 1), cA + hstep, voffA);
        if (wr == 1) PG8_BAR;
        PG8_WAIT_V(2); PG8_BAR;
        PG8_STAGE(PG8_SB(1, 0), cB + kstep, voffB); PG8_STAGE(PG8_SA(1, 0), cA + kstep, voffA); PG8_STAGE(PG8_SB(1, 1), cB + hstepB + kstep, voffB);
        PG8_WAIT_V(6); PG8_BAR;
    } else {
        PG8_STAGE(PG8_SB(0, 0), cB, voffB); PG8_STAGE(PG8_SA(0, 0), cA, voffA); PG8_STAGE(PG8_SB(0, 1), cB + hstepB, voffB); PG8_STAGE(PG8_SA(0, 1), cA + hstep, voffA);
        if (wr == 1) PG8_BAR;
        PG8_WAIT_V(4); PG8_BAR;
        PG8_STAGE(PG8_SB(1, 0), cB + kstep, voffB); PG8_STAGE(PG8_SA(1, 0), cA + kstep, voffA); PG8_STAGE(PG8_SB(1, 1), cB + hstepB + kstep, voffB);
        PG8_WAIT_V(6); PG8_BAR;
    }
    for (;;) {
        const bool has_next = S.next(ui + 1, nxt);
        const char* nA = has_next ? g.a_ptr(nxt.pm) : cA; const char* nB = has_next ? (const char*)g.Bt + (size_t)nxt.pn * tstep : cB;
        for (int t = 0; t < nt; t += 2) {
            const bool last = (t == nt - 2);
            const char* a1 = cA + (size_t)(t + 1) * kstep;
            const char* a2 = last ? nA : cA + (size_t)(t + 2) * kstep; const char* b2 = last ? nB : cB + (size_t)(t + 2) * kstep;
            const char* a3 = a2 + kstep; const char* b3 = b2 + kstep;
            if (last && has_next) S.a_ready(nxt);
            if constexpr (SP2) {
            PG8_LDB(B0, 0, 0); PG8_LDB(B1, 0, 1); PG8_SCHED; PG8_LDA(At, 0, 0); PG8_STAGE(PG8_SA(1, 1), a1 + hstep, voffA);
            PG8_WAIT_V(8); PG8_WAIT_L(0); PG8_BAR; PG8_MMA(0, 0, At, B0); PG8_MMA(0, 1, At, B1); PG8_BAR; PG8_SCHED;
            PG8_LDA(At, 0, 1); PG8_STAGE(PG8_SB(0, 0), b2, voffB); PG8_STAGE(PG8_SB(0, 1), b2 + hstepB, voffB); PG8_STAGE(PG8_SA(0, 0), a2, voffA);
            PG8_WAIT_V(8); PG8_WAIT_L(0); PG8_BAR; PG8_MMA(1, 0, At, B0); PG8_MMA(1, 1, At, B1); PG8_BAR; PG8_SCHED;
            PG8_LDB(B0, 1, 0); PG8_LDB(B1, 1, 1); PG8_SCHED; PG8_LDA(At, 1, 0); PG8_STAGE(PG8_SA(0, 1), a2 + hstep, voffA);
            PG8_WAIT_V(8); PG8_WAIT_L(0); PG8_BAR; PG8_MMA(0, 0, At, B0); PG8_MMA(0, 1, At, B1); PG8_BAR; PG8_SCHED;
            PG8_LDA(At, 1, 1); PG8_STAGE(PG8_SB(1, 0), b3, voffB); PG8_STAGE(PG8_SB(1, 1), b3 + hstepB, voffB); PG8_STAGE(PG8_SA(1, 0), a3, voffA);
            PG8_WAIT_V(8); PG8_WAIT_L(0); PG8_BAR; PG8_MMA(1, 0, At, B0); PG8_MMA(1, 1, At, B1); PG8_BAR; PG8_SCHED;
            } else {
            PG8_LDB(B0, 0, 0); PG8_SCHED; PG8_LDA(At, 0, 0); PG8_STAGE(PG8_SA(1, 1), a1 + hstep, voffA);
            PG8_WAIT_L(8); PG8_BAR; PG8_WAIT_L(0); PG8_MMA(0, 0, At, B0); PG8_BAR; PG8_SCHED;
            PG8_LDB(B1, 0, 1); PG8_STAGE(PG8_SB(0, 0), b2, voffB);
            PG8_BAR; PG8_WAIT_L(0); PG8_MMA(0, 1, At, B1); PG8_BAR;
            PG8_LDA(At, 0, 1); PG8_STAGE(PG8_SA(0, 0), a2, voffA);
            PG8_BAR; PG8_WAIT_L(0); PG8_MMA(1, 0, At, B0); PG8_BAR; PG8_SCHED;
            PG8_STAGE(PG8_SB(0, 1), b2 + hstepB, voffB);
            PG8_WAIT_V(6); PG8_BAR; PG8_MMA(1, 1, At, B1); PG8_BAR;
            PG8_LDB(B0, 1, 0); PG8_SCHED; PG8_LDA(At, 1, 0); PG8_STAGE(PG8_SA(0, 1), a2 + hstep, voffA);
            PG8_WAIT_L(8); PG8_BAR; PG8_WAIT_L(0); PG8_MMA(0, 0, At, B0); PG8_BAR; PG8_SCHED;
            PG8_LDB(B1, 1, 1); PG8_STAGE(PG8_SB(1, 0), b3, voffB);
            PG8_BAR; PG8_WAIT_L(0); PG8_MMA(0, 1, At, B1); PG8_BAR;
            PG8_LDA(At, 1, 1); PG8_STAGE(PG8_SA(1, 0), a3, voffA);
            PG8_BAR; PG8_WAIT_L(0); PG8_MMA(1, 0, At, B0); PG8_BAR; PG8_SCHED;
            PG8_STAGE(PG8_SB(1, 1), b3 + hstepB, voffB);
            PG8_WAIT_V(6); PG8_BAR; PG8_MMA(1, 1, At, B1); PG8_BAR;
            }
        }
        if constexpr (ALIGN_EPI) { if (wr == 0) PG8_BAR; }
        if constexpr (!Epi::AFTER_DRAIN) { E(acc, cur, wr, wc, fr, fq); S.done(cur); }
        if (!has_next) break;
#pragma unroll
        for (int a = 0; a < 2; ++a)
#pragma unroll
            for (int b = 0; b < 2; ++b)
#pragma unroll
                for (int m = 0; m < 4; ++m)
#pragma unroll
                    for (int n = 0; n < 2; ++n) acc[a][b][m][n] = (f32x4){0.f, 0.f, 0.f, 0.f};
        cur = nxt; cA = nA; cB = nB; ++ui;
        if constexpr (ALIGN_EPI) { if (wr == 1) PG8_BAR; }
    }
    PG8_WAIT_V(0);
    if constexpr (!ALIGN_EPI) { if (wr == 0) PG8_BAR; }
    PG8_BAR;
    if constexpr (Epi::AFTER_DRAIN) { E.fused(acc, cur, wr, wc, fr, fq, lds, wid, lane); S.done(cur); }
#undef PG8_SA
#undef PG8_SB
#undef PG8_STAGE
#undef PG8_LDA
#undef PG8_LDB
#undef PG8_MMA
#undef PG8_WAIT_V
#undef PG8_WAIT_L
#undef PG8_BAR
#undef PG8_SCHED
}
}

#define LAS __attribute__((address_space(3)))
typedef unsigned short bf16;
typedef short bf16x8 __attribute__((ext_vector_type(8)));
typedef short s16x4 __attribute__((ext_vector_type(4)));
typedef float f32x4 __attribute__((ext_vector_type(4)));
typedef float f32x16 __attribute__((ext_vector_type(16)));
typedef unsigned u32x4 __attribute__((ext_vector_type(4)));
typedef unsigned u32x2 __attribute__((ext_vector_type(2)));
constexpr int NWAVES = 8;
constexpr int BATCH = 8, SEQ = 4096, NMETA = 16, LT = 4112, DM = 1024, DIN = 8192, FF = 4096;
constexpr int MFLAT = BATCH * LT, MP = 33024, MQ = BATCH * SEQ;
constexpr size_t MiB = 1u << 20;
constexpr size_t WS_SS = 0, WS_ROPE = 4 * MiB, WS_WIN = 6 * MiB, WS_WA = 22 * MiB, WS_WB = 24 * MiB, WS_WO = 26 * MiB, WS_WUP = 28 * MiB, WS_WDN = 36 * MiB;
constexpr size_t WS_SEC = 44 * MiB, SEC_BYTES = 65 * MiB, SEC_ELEMS = SEC_BYTES / 2;
constexpr size_t WS_HN = WS_SEC + 6 * SEC_BYTES, WS_END = WS_HN + 65 * MiB;
static_assert((size_t)MP * 1024 * 2 <= SEC_BYTES && (size_t)MQ * 4096 * 2 <= 4 * SEC_BYTES, "ws map");
constexpr size_t WS_R2 = 2 * MiB;
constexpr size_t WS_HNM = 5 * MiB + 256 * 1024;
constexpr size_t WS_BAR = 5 * MiB + 512 * 1024;
constexpr int LDS_BYTES = 131072 + 1024 + 8 * 16 * 144, LDS_BARW = 131072 + 512;
constexpr float LOG2E = 1.4426950408889634f, LN2 = 0.6931471805599453f, EPS = 1e-6f;

struct Frame {
    LAS unsigned char* lds; int tid, lane, wave, vcu, G;
    const float* in[16]; float* out; unsigned char* ws;
};
__device__ __forceinline__ float wave_sum(float v) {
#pragma unroll
    for (int o = 1; o < 64; o <<= 1) v += __shfl_xor(v, o);
    return v;
}
__device__ __forceinline__ unsigned cvtpk(float lo, float hi) { return pg8::cvt_pk_bf16(lo, hi); }

template <bool ROPEPERM> __device__ __forceinline__ void p0_transpose_item(const float* W, int K, int N, bf16* WT, const float* gk, LAS float* scr, int item, int lane) {
    const int nblk = N / 32, kb = item / nblk, nb = item % nblk, k0 = 64 * kb, n0 = 32 * nb;
    int src = n0 + (lane & 31);
    if (ROPEPERM && src < 2048) { const int w = src & 63; src = (src & ~63) + (w >> 1) + 32 * (w & 1); }
    float wv_[32];
#pragma unroll
    for (int i = 0; i < 32; ++i) { const int kk = 2 * i + (lane >> 5); wv_[i] = W[(size_t)(k0 + kk) * N + src]; }
#pragma unroll
    for (int i = 0; i < 32; ++i) { const int kk = 2 * i + (lane >> 5); float v = wv_[i]; if (gk) v *= gk[k0 + kk]; scr[kk * 33 + (lane & 31)] = v; }
    asm volatile("s_waitcnt lgkmcnt(0)" ::: "memory");
    const int c = lane & 7;
#pragma unroll
    for (int j = 0; j < 4; ++j) { const int n = (lane >> 3) + 8 * j; const LAS float* s = scr + (8 * c) * 33 + n;
        u32x4 o; o.x = cvtpk(s[0 * 33], s[1 * 33]); o.y = cvtpk(s[2 * 33], s[3 * 33]); o.z = cvtpk(s[4 * 33], s[5 * 33]); o.w = cvtpk(s[6 * 33], s[7 * 33]);
        *(u32x4*)(WT + (size_t)(n0 + n) * K + k0 + 8 * c) = o; }
    asm volatile("s_waitcnt lgkmcnt(0)" ::: "memory");
}
__device__ __forceinline__ void p0_prologue(const Frame& F) {
    LAS float* scr = (LAS float*)(F.lds + F.wave * 16384);
    const int gw = F.vcu * NWAVES + F.wave, NGW = F.G * NWAVES;
    unsigned char* ws = F.ws;
    constexpr int I_IN = 16 * 256, I_SQ = 16 * 32, I_UP = 16 * 128, I_DN = 64 * 32, NITEMS = I_IN + 3 * I_SQ + I_UP + I_DN;
    for (int it = gw; it < NITEMS; it += NGW) {
        int r = it;
        if (r < I_IN) { p0_transpose_item<true>(F.in[3], DM, DIN, (bf16*)(ws + WS_WIN), nullptr, scr, r, F.lane); continue; } r -= I_IN;
        if (r < I_SQ) { p0_transpose_item<false>(F.in[9], DM, DM, (bf16*)(ws + WS_WA), nullptr, scr, r, F.lane); continue; } r -= I_SQ;
        if (r < I_SQ) { p0_transpose_item<false>(F.in[10], DM, DM, (bf16*)(ws + WS_WB), nullptr, scr, r, F.lane); continue; } r -= I_SQ;
        if (r < I_SQ) { p0_transpose_item<false>(F.in[11], DM, DM, (bf16*)(ws + WS_WO), nullptr, scr, r, F.lane); continue; } r -= I_SQ;
        if (r < I_UP) { p0_transpose_item<false>(F.in[13], DM, FF, (bf16*)(ws + WS_WUP), F.in[12], scr, r, F.lane); continue; } r -= I_UP;
        p0_transpose_item<false>(F.in[14], FF, DM, (bf16*)(ws + WS_WDN), nullptr, scr, r, F.lane);
    }
    bf16* HN = (bf16*)(ws + WS_HN); bf16* HNM = (bf16*)(ws + WS_HNM);
    const f32x4* g4 = (const f32x4*)F.in[2] + F.lane;
    constexpr int NR = 4;
    for (int R0 = gw; R0 < MQ + NMETA; R0 += NR * NGW) {
        f32x4 v[NR][4]; float sq[NR]; bool has[NR]; int Rr[NR];
#pragma unroll
        for (int rr = 0; rr < NR; ++rr) { const int R = R0 + rr * NGW; has[rr] = R < MQ + NMETA; Rr[rr] = has[rr] ? R : R0;
            const f32x4* xr = (const f32x4*)(Rr[rr] < MQ ? F.in[0] + (size_t)Rr[rr] * DM : F.in[1] + (size_t)(Rr[rr] - MQ) * DM) + F.lane;
#pragma unroll
            for (int j = 0; j < 4; ++j) v[rr][j] = xr[64 * j]; }
#pragma unroll
        for (int rr = 0; rr < NR; ++rr) { float s = 0.f;
#pragma unroll
            for (int j = 0; j < 4; ++j) s += (v[rr][j].x * v[rr][j].x + v[rr][j].y * v[rr][j].y) + (v[rr][j].z * v[rr][j].z + v[rr][j].w * v[rr][j].w);
            sq[rr] = s; }
#pragma unroll
        for (int rr = 0; rr < NR; ++rr) { const float rstd = 1.0f / sqrtf(wave_sum(sq[rr]) * (1.0f / DM) + EPS);
            u32x2* o8 = (u32x2*)(Rr[rr] < MQ ? HN + (size_t)Rr[rr] * DM : HNM + (size_t)(Rr[rr] - MQ) * DM) + F.lane;
            if (has[rr]) {
#pragma unroll
                for (int j = 0; j < 4; ++j) { const f32x4 g = g4[64 * j]; o8[64 * j] = (u32x2){cvtpk(v[rr][j].x * rstd * g.x, v[rr][j].y * rstd * g.y), cvtpk(v[rr][j].z * rstd * g.z, v[rr][j].w * rstd * g.w)}; } } }
    }
    float* rope = (float*)(ws + WS_ROPE);
    for (int idx = (F.vcu * NWAVES * 64) + F.tid; idx < LT * 32; idx += F.G * NWAVES * 64) {
        const int pos = idx >> 5, i = idx & 31;
        const float inv = (float)exp(-(double)i * (9.210340371976184 / 32.0));
        const float ang = (float)pos * inv;
        const double a = (double)ang; const double k = rint(a * 0.15915494309189535); const double rr = fma(-k, 6.283185307179586, a) - k * 2.4492935982947064e-16;
        const float rf = (float)rr;
        rope[2 * idx] = cosf(rf); rope[2 * idx + 1] = sinf(rf);
    }
}

__device__ __forceinline__ int crow(int r, int hi) { return (r & 3) + 8 * (r >> 2) + 4 * hi; }
typedef short v4i16_t __attribute__((ext_vector_type(4)));
__device__ __forceinline__ s16x4 vtr(const LAS unsigned char* p) { return __builtin_bit_cast(s16x4, __builtin_amdgcn_ds_read_tr16_b64_v4i16((LAS v4i16_t*)p)); }
#define MFMA32(a, b, c) __builtin_amdgcn_mfma_f32_32x32x16_bf16((a), (b), (c), 0, 0, 0)
__device__ __forceinline__ bf16x8 pack_step(const f32x16& x, int s) {
    u32x4 p; p.x = cvtpk(x[8 * s], x[8 * s + 1]); p.y = cvtpk(x[8 * s + 2], x[8 * s + 3]); p.z = cvtpk(x[8 * s + 4], x[8 * s + 5]); p.w = cvtpk(x[8 * s + 6], x[8 * s + 7]);
    return __builtin_bit_cast(bf16x8, p);
}
#define VFRAG(ptr, off0, STR) ({ const s16x4 lo_ = vtr((ptr) + (off0)); const s16x4 hi_ = vtr((ptr) + (off0) + 8 * (STR)); (bf16x8){lo_[0], lo_[1], lo_[2], lo_[3], hi_[0], hi_[1], hi_[2], hi_[3]}; })

constexpr int DK_STR = 272, DV_STR = 320, DK_BUF = 64 * DK_STR, DV_BUF = 64 * DV_STR, D_KOFF = 0, D_VOFF = 2 * DK_BUF;
__device__ __forceinline__ void diff_unit(const Frame& F, int b, int h, int qi, float lam, int dry) {
    LAS unsigned char* lds = F.lds;
    const int tid = F.tid, lane = F.lane, wid = F.wave, r32 = lane & 31, hi = lane >> 5;
    const int map = wid >> 2, wq = wid & 3;
    const size_t rowbase = (size_t)b * LT;
    const int tq0 = NMETA + 128 * qi, tqw = tq0 + 32 * wq, tq = tqw + r32;
    bf16* QA = (bf16*)(F.ws + WS_SEC); const bf16* KA = QA + SEC_ELEMS; const bf16* VA = QA + 2 * SEC_ELEMS;
    bf16x8 qf[4];
    { const bf16* qp = QA + (rowbase + tq) * 1024 + 128 * h + 64 * map + 8 * hi;
#pragma unroll
      for (int ks = 0; ks < 4; ++ks) qf[ks] = *(const bf16x8*)(qp + 16 * ks); }
    const int srow = tid >> 4, sc16 = tid & 15;
    const bf16* kg = KA + (rowbase + srow) * 1024 + 128 * h + sc16 * 8;
    const bf16* vg = VA + (rowbase + srow) * 1024 + 128 * h + sc16 * 8;
    const int klds = D_KOFF + srow * DK_STR + sc16 * 16, vlds = D_VOFF + srow * DV_STR + sc16 * 16;
    u32x4 st0, st1, st2, st3;
#define D_LOAD(key0) do { st0 = *(const u32x4*)(kg + (size_t)(key0) * 1024); st1 = *(const u32x4*)(kg + (size_t)((key0) + 32) * 1024); st2 = *(const u32x4*)(vg + (size_t)(key0) * 1024); st3 = *(const u32x4*)(vg + (size_t)((key0) + 32) * 1024); } while (0)
#define D_STORE(buf) do { *(LAS u32x4*)(lds + klds + (buf) * DK_BUF) = st0; *(LAS u32x4*)(lds + klds + (buf) * DK_BUF + 32 * DK_STR) = st1; *(LAS u32x4*)(lds + vlds + (buf) * DV_BUF) = st2; *(LAS u32x4*)(lds + vlds + (buf) * DV_BUF + 32 * DV_STR) = st3; } while (0)
    const int nt = 2 * qi + 3;
    __syncthreads();
    D_LOAD(0); D_STORE(0);
    __syncthreads();
    f32x16 O[4];
#pragma unroll
    for (int dt = 0; dt < 4; ++dt)
#pragma unroll
        for (int r = 0; r < 16; ++r) O[dt][r] = 0.f;
    float ms = -INFINITY, lsum = 0.f;
    const int kra = D_KOFF + r32 * DK_STR + map * 128 + hi * 16;
    const int vra = D_VOFF + (4 * hi + ((lane & 15) >> 2)) * DV_STR + (16 * ((lane >> 4) & 1) + 4 * (lane & 3)) * 2;
    for (int it = 0; it < nt; ++it) {
        const int key0 = it == 0 ? 0 : NMETA + 64 * (it - 1);
        if (it + 1 < nt) D_LOAD(NMETA + 64 * it);
        const bool meta = (it == 0);
        if (meta || key0 <= tqw + 31) {
            const LAS unsigned char* kb = lds + kra + (it & 1) * DK_BUF;
            const LAS unsigned char* vb = lds + vra + (it & 1) * DV_BUF;
            f32x16 s0, s1;
#pragma unroll
            for (int r = 0; r < 16; ++r) { s0[r] = 0.f; s1[r] = 0.f; }
            bf16x8 vpre0 = VFRAG(vb, 0, DV_STR), vpre1 = VFRAG(vb, 64, DV_STR), vpre2 = VFRAG(vb, 128, DV_STR), vpre3 = VFRAG(vb, 192, DV_STR);
            bf16x8 vprf0 = VFRAG(vb, 16 * DV_STR, DV_STR), vprf1 = VFRAG(vb, 16 * DV_STR + 64, DV_STR);
            __builtin_amdgcn_s_setprio(1);
#pragma unroll
            for (int ks = 0; ks < 4; ++ks) { const bf16x8 k0 = *(const LAS bf16x8*)(kb + ks * 32); s0 = MFMA32(k0, qf[ks], s0); }
            if (!meta) {
#pragma unroll
                for (int ks = 0; ks < 4; ++ks) { const bf16x8 k1 = *(const LAS bf16x8*)(kb + 32 * DK_STR + ks * 32); s1 = MFMA32(k1, qf[ks], s1); }
            }
            __builtin_amdgcn_s_setprio(0);
            if (meta) {
#pragma unroll
                for (int r = 8; r < 16; ++r) s0[r] = -INFINITY;
#pragma unroll
                for (int r = 0; r < 16; ++r) s1[r] = -INFINITY;
            } else if (key0 + 63 > tqw) {
#pragma unroll
                for (int r = 0; r < 16; ++r) { const int c = (r & 3) + 8 * (r >> 2), lim = tq - key0 - 4 * hi; if (c > lim) s0[r] = -INFINITY; if (c + 32 > lim) s1[r] = -INFINITY; }
            }
            float mx = fmaxf(s0[0], s1[0]);
#pragma unroll
            for (int r = 1; r < 16; ++r) mx = fmaxf(mx, fmaxf(s0[r], s1[r]));
            mx = fmaxf(mx, __shfl_xor(mx, 32));
            const float mxs = mx * LOG2E;
            if (__any(mxs > ms + 8.0f)) {
                const float msn = fmaxf(ms, mxs); const float f = __builtin_amdgcn_exp2f(ms - msn); lsum *= f; ms = msn;
#pragma unroll
                for (int dt = 0; dt < 4; ++dt)
#pragma unroll
                    for (int r = 0; r < 16; ++r) O[dt][r] *= f;
            }
            float ps = 0.f;
#pragma unroll
            for (int r = 0; r < 16; ++r) { s0[r] = __builtin_amdgcn_exp2f(s0[r] * LOG2E - ms); ps += s0[r]; }
            if (!meta) {
#pragma unroll
                for (int r = 0; r < 16; ++r) { s1[r] = __builtin_amdgcn_exp2f(s1[r] * LOG2E - ms); ps += s1[r]; }
            }
            lsum += ps;
            __builtin_amdgcn_s_setprio(1);
            { const bf16x8 pf = pack_step(s0, 0);
              O[0] = MFMA32(vpre0, pf, O[0]); O[1] = MFMA32(vpre1, pf, O[1]); O[2] = MFMA32(vpre2, pf, O[2]); O[3] = MFMA32(vpre3, pf, O[3]); }
            if (!meta) {
                { const bf16x8 pf = pack_step(s0, 1);
                  O[0] = MFMA32(vprf0, pf, O[0]); O[1] = MFMA32(vprf1, pf, O[1]);
#pragma unroll
                  for (int dt = 2; dt < 4; ++dt) { const bf16x8 vf = VFRAG(vb, 16 * DV_STR + 64 * dt, DV_STR); O[dt] = MFMA32(vf, pf, O[dt]); } }
#pragma unroll
                for (int s2 = 0; s2 < 2; ++s2) { const bf16x8 pf = pack_step(s1, s2);
#pragma unroll
                    for (int dt = 0; dt < 4; ++dt) { const bf16x8 vf = VFRAG(vb, (32 + 16 * s2) * DV_STR + 64 * dt, DV_STR); O[dt] = MFMA32(vf, pf, O[dt]); } }
            }
            __builtin_amdgcn_s_setprio(0);
        }
        if (it + 1 < nt) D_STORE((it + 1) & 1);
        __syncthreads();
    }
#undef D_LOAD
#undef D_STORE
    const float lt = lsum + __shfl_xor(lsum, 32);
    LAS float* xch = (LAS float*)lds + (size_t)(wq * 64) * 64 + lane;
    if (map == 1) { const float sc = lam / lt;
#pragma unroll
        for (int dt = 0; dt < 4; ++dt)
#pragma unroll
            for (int r = 0; r < 16; ++r) xch[(dt * 16 + r) * 64] = O[dt][r] * sc; }
    __syncthreads();
    if (map == 0 && !dry) { const float il = 1.0f / lt; float q = 0.f;
#pragma unroll
        for (int dt = 0; dt < 4; ++dt)
#pragma unroll
            for (int r = 0; r < 16; ++r) { const float o = O[dt][r] * il - xch[(dt * 16 + r) * 64]; O[dt][r] = o; q += o * o; }
        q += __shfl_xor(q, 32);
        const float rs = 0.8f / sqrtf(q * (1.0f / 128.0f) + EPS);
        LAS unsigned char* stg = lds + (size_t)wq * (64 * 64 * 4);
        const float* sg = F.in[8];
#pragma unroll
        for (int dt = 0; dt < 4; ++dt)
#pragma unroll
            for (int c = 0; c < 4; ++c) { const int d = 32 * dt + 8 * c + 4 * hi; const f32x4 g = *(const f32x4*)(sg + d);
                *(LAS u32x2*)(stg + r32 * 272 + 2 * d) = (u32x2){cvtpk(O[dt][4 * c] * rs * g.x, O[dt][4 * c + 1] * rs * g.y), cvtpk(O[dt][4 * c + 2] * rs * g.z, O[dt][4 * c + 3] * rs * g.w)}; }
        bf16* ob = QA + (rowbase + tqw) * 1024 + 128 * h;
#pragma unroll
        for (int j = 0; j < 8; ++j) { const int id = lane + 64 * j, row = id >> 4, ch = id & 15; const u32x4 v = *(const LAS u32x4*)(stg + row * 272 + ch * 16); *(u32x4*)(ob + (size_t)row * 1024 + ch * 8) = v; }
    }
}

constexpr int SK_STR = 144, SV_STR = 192, SK_BUF = 128 * SK_STR, SV_BUF = 128 * SV_STR, S_KOFF = 0, S_VOFF = 2 * SK_BUF;
__device__ __forceinline__ void sb_unit(const Frame& F, int b, int hd, int qi, int dry) {
    LAS unsigned char* lds = F.lds;
    const int tid = F.tid, lane = F.lane, wid = F.wave, r32 = lane & 31, hi = lane >> 5;
    const size_t rowbase = (size_t)b * LT;
    const int tq0 = NMETA + 256 * qi, tqw = tq0 + 32 * wid, tq = tqw + r32;
    bf16* QB = (bf16*)(F.ws + WS_SEC) + 3 * SEC_ELEMS; const bf16* KB = QB + SEC_ELEMS; const bf16* VB = QB + 2 * SEC_ELEMS;
    bf16x8 qf[4];
    { const bf16* qp = QB + (rowbase + tq) * 1024 + 64 * hd + 8 * hi;
#pragma unroll
      for (int ks = 0; ks < 4; ++ks) qf[ks] = *(const bf16x8*)(qp + 16 * ks); }
    const int srow = tid >> 3, sc16 = tid & 7;
    const bf16* kg = KB + (rowbase + srow) * 1024 + 64 * hd + sc16 * 8;
    const bf16* vg = VB + (rowbase + srow) * 1024 + 64 * hd + sc16 * 8;
    const int klds = S_KOFF + srow * SK_STR + sc16 * 16, vlds = S_VOFF + srow * SV_STR + sc16 * 16;
    u32x4 st0, st1, st2, st3;
#define S_LOAD(key0) do { st0 = *(const u32x4*)(kg + (size_t)(key0) * 1024); st1 = *(const u32x4*)(kg + (size_t)((key0) + 64) * 1024); st2 = *(const u32x4*)(vg + (size_t)(key0) * 1024); st3 = *(const u32x4*)(vg + (size_t)((key0) + 64) * 1024); } while (0)
#define S_STORE(buf) do { *(LAS u32x4*)(lds + klds + (buf) * SK_BUF) = st0; *(LAS u32x4*)(lds + klds + (buf) * SK_BUF + 64 * SK_STR) = st1; \
        *(LAS u32x4*)(lds + vlds + (buf) * SV_BUF) = st2; *(LAS u32x4*)(lds + vlds + (buf) * SV_BUF + 64 * SV_STR) = st3; } while (0)
    const int jmax = 2 * qi + 1, nt = jmax + 2;
    __syncthreads();
    S_LOAD(NMETA + 128 * jmax); S_STORE(0);
    __syncthreads();
    f32x16 O[2];
#pragma unroll
    for (int dt = 0; dt < 2; ++dt)
#pragma unroll
        for (int r = 0; r < 16; ++r) O[dt][r] = 0.f;
    float C = 0.f;
    bool dead = false;
    constexpr float SB_DEAD = -160.0f;
    LAS int* flags = (LAS int*)(lds + S_VOFF + 2 * SV_BUF);
    const int kra = S_KOFF + r32 * SK_STR + hi * 16;
    const int vra = S_VOFF + (4 * hi + ((lane & 15) >> 2)) * SV_STR + (16 * ((lane >> 4) & 1) + 4 * (lane & 3)) * 2;
    for (int it = 0; it < nt; ++it) {
        const bool meta = (it > jmax);
        const int key0 = meta ? 0 : NMETA + 128 * (jmax - it);
        if (it + 1 < nt) { const int nk = (it + 1 > jmax) ? 0 : NMETA + 128 * (jmax - it - 1); S_LOAD(nk); }
        if (!dead && (meta || key0 < tqw + 31)) {
            const LAS unsigned char* kb = lds + kra + (it & 1) * SK_BUF;
            const LAS unsigned char* vb = lds + vra + (it & 1) * SV_BUF;
#define SB_HALF(KO)  do { f32x16 S_, om_; \
                  \
                const bf16x8 vq0_ = VFRAG(vb, (KO) * SV_STR, SV_STR), vq1_ = VFRAG(vb, (KO) * SV_STR + 64, SV_STR), vq2_ = VFRAG(vb, ((KO) + 16) * SV_STR, SV_STR), vq3_ = VFRAG(vb, ((KO) + 16) * SV_STR + 64, SV_STR); \
                _Pragma("unroll") for (int r = 0; r < 16; ++r) S_[r] = 0.f; \
                _Pragma("unroll") for (int ks = 0; ks < 4; ++ks) { const bf16x8 kf_ = *(const LAS bf16x8*)(kb + (KO) * SK_STR + ks * 32); S_ = MFMA32(kf_, qf[ks], S_); } \
                const int lim_ = (meta ? NMETA : tq) - key0 - (KO) - 4 * hi;     \
                  \
                  \
                  \
                const float sc_ = __builtin_amdgcn_exp2f(run); \
                _Pragma("unroll") for (int r = 0; r < 16; ++r) { const float z = fmaxf(S_[r], -126.0f); const bool valid = (r & 3) + 8 * (r >> 2) < lim_; const float e = __builtin_amdgcn_exp2f(-z); \
                    const float bt = __builtin_amdgcn_rcpf(1.0f + e); om_[r] = valid ? e * bt : 1.0f; S_[r] = valid ? bt * sc_ : 0.f; } \
                float rp_ = 1.0f; \
                _Pragma("unroll") for (int c = 3; c >= 0; --c) { const float cs = (om_[4 * c] * om_[4 * c + 1]) * (om_[4 * c + 2] * om_[4 * c + 3]); const float co = __shfl_xor(cs, 32); \
                    const float e3 = rp_ * (hi == 0 ? co : 1.0f), e2 = e3 * om_[4 * c + 3], e1 = e2 * om_[4 * c + 2], e0 = e1 * om_[4 * c + 1]; \
                    S_[4 * c + 3] *= e3; S_[4 * c + 2] *= e2; S_[4 * c + 1] *= e1; S_[4 * c] *= e0; \
                    rp_ *= cs * co; } \
                run += __builtin_amdgcn_logf(rp_);     \
                { const bf16x8 pf0_ = pack_step(S_, 0), pf1_ = pack_step(S_, 1); \
                  O[0] = MFMA32(vq0_, pf0_, O[0]); O[1] = MFMA32(vq1_, pf0_, O[1]); O[0] = MFMA32(vq2_, pf1_, O[0]); O[1] = MFMA32(vq3_, pf1_, O[1]); } \
            } while (0)
            float run = C;
            if (!meta && key0 + 96 < tqw + 31) SB_HALF(96);
            if (!meta && key0 + 64 < tqw + 31 && __any(run >= SB_DEAD)) SB_HALF(64);
            if (!meta && key0 + 32 < tqw + 31 && __any(run >= SB_DEAD)) SB_HALF(32);
            if (__any(run >= SB_DEAD)) SB_HALF(0);
            C = run; dead = !__any(C >= SB_DEAD);
#undef SB_HALF
        }
        if (it + 1 < nt) S_STORE((it + 1) & 1);
        if (lane == 0) flags[(it & 1) * 8 + wid] = dead ? 1 : 0;
        __syncthreads();
        if (!__any(flags[(it & 1) * 8 + (lane & 7)] == 0)) break;
    }
#undef S_LOAD
#undef S_STORE
    if (dry) return;
    LAS unsigned char* stg = lds + (size_t)wid * (32 * 144);
#pragma unroll
    for (int dt = 0; dt < 2; ++dt)
#pragma unroll
        for (int c = 0; c < 4; ++c) { const int d = 32 * dt + 8 * c + 4 * hi;
            *(LAS u32x2*)(stg + r32 * 144 + 2 * d) = (u32x2){cvtpk(O[dt][4 * c], O[dt][4 * c + 1]), cvtpk(O[dt][4 * c + 2], O[dt][4 * c + 3])}; }
    bf16* ob = QB + (rowbase + tqw) * 1024 + 64 * hd;
#pragma unroll
    for (int j = 0; j < 4; ++j) { const int id = lane + 64 * j, row = id >> 3, ch = id & 7; const u32x4 v = *(const LAS u32x4*)(stg + row * 144 + ch * 16); *(u32x4*)(ob + (size_t)row * 1024 + ch * 8) = v; }
}
__device__ __forceinline__ void attn_phase(const Frame& F) {
    const float a1 = wave_sum(F.in[4][F.lane] * F.in[5][F.lane]), a2 = wave_sum(F.in[6][F.lane] * F.in[7][F.lane]);
    const float lam = expf(a1) - expf(a2) + 0.2f;
    for (int rep = PROBE_DIFF ? 0 : 1; rep < 2; ++rep)
    for (int pidx = F.vcu; pidx < 1024; pidx += F.G) {
        const int bh = pidx >> 4, p = pidx & 15;
        diff_unit(F, bh >> 3, bh & 7, p, lam, rep == 0);
        diff_unit(F, bh >> 3, bh & 7, 31 - p, lam, rep == 0);
    }
    for (int rep = PROBE_SB ? 0 : 1; rep < 2; ++rep)
    for (int pidx = F.vcu; pidx < 1024; pidx += F.G) {
        const int bh = pidx >> 3, p = pidx & 7;
        sb_unit(F, bh >> 4, bh & 15, p, rep == 0);
        sb_unit(F, bh >> 4, bh & 15, 15 - p, rep == 0);
    }
    __syncthreads();
}
__device__ __forceinline__ void final_norm(const Frame& F) {
    const int gw = F.vcu * NWAVES + F.wave, NGW = F.G * NWAVES;
    const f32x4* g4 = (const f32x4*)F.in[15] + F.lane;
    const bf16* H3 = (const bf16*)(F.ws + WS_SEC) + 5 * SEC_ELEMS;
    constexpr int NR = 4;
    for (int R0 = gw; R0 < MQ; R0 += NR * NGW) {
        u32x2 w[NR][4]; bool has[NR]; int Rr[NR];
#pragma unroll
        for (int rr = 0; rr < NR; ++rr) { const int R = R0 + rr * NGW; has[rr] = R < MQ; Rr[rr] = has[rr] ? R : R0; const u32x2* hr = (const u32x2*)(H3 + (size_t)Rr[rr] * DM) + F.lane;
#pragma unroll
            for (int j = 0; j < 4; ++j) w[rr][j] = hr[64 * j]; }
#pragma unroll
        for (int rr = 0; rr < NR; ++rr) { f32x4 v[4]; float s = 0.f;
#pragma unroll
            for (int j = 0; j < 4; ++j) { v[j] = (f32x4){pg8::bf_lo(w[rr][j].x), pg8::bf_hi(w[rr][j].x), pg8::bf_lo(w[rr][j].y), pg8::bf_hi(w[rr][j].y)}; s += (v[j].x * v[j].x + v[j].y * v[j].y) + (v[j].z * v[j].z + v[j].w * v[j].w); }
            const float rstd = 1.0f / sqrtf(wave_sum(s) * (1.0f / DM) + EPS);
            f32x4* xr = (f32x4*)(F.out + (size_t)Rr[rr] * DM) + F.lane;
            if (has[rr]) {
#pragma unroll
                for (int j = 0; j < 4; ++j) xr[64 * j] = v[j] * rstd * g4[64 * j]; } }
    }
}

__device__ __forceinline__ void meta_proj(const Frame& F, int v) {
    const int lane = F.lane, w = F.wave, cbk = w & 1, kq = w >> 1, n0 = 32 * v;
    const bf16* ap = (const bf16*)(F.ws + WS_HNM) + (size_t)(lane & 15) * DM + 256 * kq + 8 * (lane >> 4);
    const bf16* bp = (const bf16*)(F.ws + WS_WIN) + (size_t)(n0 + 16 * cbk + (lane & 15)) * DM + 256 * kq + 8 * (lane >> 4);
    bf16x8 af[8], bfr[8];
#pragma unroll
    for (int ks = 0; ks < 8; ++ks) { af[ks] = *(const bf16x8*)(ap + 32 * ks); bfr[ks] = *(const bf16x8*)(bp + 32 * ks); }
    f32x4 acc = {0.f, 0.f, 0.f, 0.f};
#pragma unroll
    for (int ks = 0; ks < 8; ++ks) acc = __builtin_amdgcn_mfma_f32_16x16x32_bf16(af[ks], bfr[ks], acc, 0, 0, 0);
    LAS f32x4* red = (LAS f32x4*)F.lds;
    red[(kq * 2 + cbk) * 64 + lane] = acc;
    __syncthreads();
    if (kq == 0) {
        const f32x4 s = (red[(0 * 2 + cbk) * 64 + lane] + red[(1 * 2 + cbk) * 64 + lane]) + (red[(2 * 2 + cbk) * 64 + lane] + red[(3 * 2 + cbk) * 64 + lane]);
        const int c = n0 + 16 * cbk + (lane & 15), sec = c >> 10, cs = c & 1023;
        bf16* base = (bf16*)(F.ws + WS_SEC) + (size_t)sec * SEC_ELEMS + cs;
        const float* rope = (const float*)(F.ws + WS_ROPE);
#pragma unroll
        for (int i = 0; i < 4; ++i) { const int t = 4 * (lane >> 4) + i; float val = s[i];
            if (sec < 2) {
                const float o = __shfl_xor(val, 1); const int ip = (cs & 63) >> 1; const float cc = rope[(t * 32 + ip) * 2], sn = rope[(t * 32 + ip) * 2 + 1];
                val = (lane & 1) ? val * cc + o * sn : val * cc - o * sn;
                if (sec == 0) val *= 0.125f;
            } else if (sec == 3) val *= 0.125f * LOG2E;
            const unsigned short hb = (unsigned short)(cvtpk(val, 0.f) & 0xffffu);
#pragma unroll
            for (int b = 0; b < BATCH; ++b) base[((size_t)b * LT + t) * 1024] = hb; }
    }
    __syncthreads();
}

#define XB_TMO      128
#define XB_XCNT(j)  (256  + 64 * (j))
#define XB_XSUB(j)  (1280 + 64 * (j))
#define XB_XGEN(j)  (2304 + 64 * (j))
#define XB_TOP      3328
#define XB_TOPGEN   3392
#define XCD_BAR_WORDS 3456
#define XB_SPIN_CAP (1u << 18)

__device__ __forceinline__ unsigned xb_ld(unsigned* p)              { return __hip_atomic_load(p, __ATOMIC_RELAXED, __HIP_MEMORY_SCOPE_AGENT); }
__device__ __forceinline__ unsigned xb_add(unsigned* p, unsigned v) { return __hip_atomic_fetch_add(p, v, __ATOMIC_RELAXED, __HIP_MEMORY_SCOPE_AGENT); }
__device__ __forceinline__ unsigned xb_xcc_id() { return (unsigned)__builtin_amdgcn_s_getreg((3 << 11) | 20) & 0xFu; }
#define XB_SPIN(cond, bar) do { unsigned _sp = 0; while (cond) { __builtin_amdgcn_s_sleep(1); \
    if ((++_sp & 255u) == 0u) { if (xb_ld(&(bar)[XB_TMO])) break; if (_sp > XB_SPIN_CAP) { atomicAdd(&(bar)[XB_TMO], 1u); break; } } } } while (0)

struct XcdBarrier {
    unsigned* bar; unsigned x;
    volatile LAS unsigned* st;
};

__device__ __forceinline__ XcdBarrier xcd_barrier_post(unsigned* bar, volatile LAS unsigned* st) {
    XcdBarrier b; b.bar = bar; b.x = xb_xcc_id(); b.st = st;
    if (threadIdx.x == 0) (void)xb_add(&bar[XB_XCNT(b.x)], 1u);
    return b;
}
__device__ __forceinline__ void xcd_barrier_complete(unsigned* bar, unsigned x, unsigned& nloc, unsigned& nx) {
    const unsigned G = gridDim.x * gridDim.y * gridDim.z;
    unsigned sum, cnt, mine, sp = 0u;
    for (;;) {
        sum = 0u; cnt = 0u; mine = 0u;
#pragma unroll
        for (unsigned j = 0; j < 16; ++j) { const unsigned c = xb_ld(&bar[XB_XCNT(j)]); sum += c; cnt += (c > 0u) ? 1u : 0u; mine = (j == x) ? c : mine; }
        if (sum == G) break;
        __builtin_amdgcn_s_sleep(1);
        if ((++sp & 255u) == 0u) { if (xb_ld(&bar[XB_TMO])) break; if (sp > XB_SPIN_CAP) { atomicAdd(&bar[XB_TMO], 1u); break; } }
    }
    nloc = mine > 0u ? mine : 1u; nx = cnt > 0u ? cnt : 1u;
}

__device__ __forceinline__ void xcd_barrier(const XcdBarrier& b) {
    asm volatile("s_waitcnt vmcnt(0)" ::: "memory");
    __syncthreads();
    if (threadIdx.x == 0) {
        unsigned* bar = b.bar;
        __builtin_amdgcn_s_waitcnt(0);
        unsigned nloc = b.st[0], nx = b.st[1];
        if (nloc == 0u) { xcd_barrier_complete(bar, b.x, nloc, nx); b.st[0] = nloc; b.st[1] = nx; }
        const unsigned old = xb_add(&bar[XB_XSUB(b.x)], 1u);
        const unsigned gen = old / nloc;
        if (old + 1u == (gen + 1u) * nloc) {
            __builtin_amdgcn_fence(__ATOMIC_RELEASE, "agent");
            asm volatile("s_waitcnt vmcnt(0)" ::: "memory");
            const unsigned og = xb_add(&bar[XB_TOP], 1u);
            const unsigned tg = og / nx;
            if (og + 1u == (tg + 1u) * nx) xb_add(&bar[XB_TOPGEN], 1u);
            else XB_SPIN(xb_ld(&bar[XB_TOPGEN]) == tg, bar);
            __builtin_amdgcn_fence(__ATOMIC_ACQUIRE, "agent");
            xb_add(&bar[XB_XGEN(b.x)], 1u);
            asm volatile("s_waitcnt vmcnt(0)" ::: "memory");
        } else {
            XB_SPIN(xb_ld(&bar[XB_XGEN(b.x)]) == gen, bar);
            __builtin_amdgcn_fence(__ATOMIC_ACQUIRE, "agent");
            asm volatile("s_waitcnt vmcnt(0)" ::: "memory");
        }
    }
    __syncthreads();
}

struct Args { const float* in[16]; float* out; unsigned char* ws; int ph_lo, ph_hi; };
__global__ void __launch_bounds__(NWAVES * 64, 2) mk_fwd(Args args) {
    extern __shared__ __attribute__((aligned(16))) unsigned char lds_raw[];
    cg::grid_group grid = cg::this_grid();
    Frame F;
    F.lds = (LAS unsigned char*)lds_raw;
    F.tid = threadIdx.x; F.lane = F.tid & 63; F.wave = __builtin_amdgcn_readfirstlane(F.tid >> 6);
    F.G = gridDim.x; { const int bx = blockIdx.x; F.vcu = (F.G % 8 == 0) ? (bx % 8) * (F.G / 8) + bx / 8 : bx; }
#pragma unroll
    for (int i = 0; i < 16; ++i) F.in[i] = args.in[i];
    F.out = args.out; F.ws = args.ws;
    unsigned char* ws = args.ws;
    const int lo = args.ph_lo, hi = args.ph_hi;
    volatile LAS unsigned* barst = (volatile LAS unsigned*)(F.lds + LDS_BARW);
    if (F.tid < 4) barst[F.tid] = 0u;
    __syncthreads();
    XcdBarrier xbar = xcd_barrier_post((unsigned*)(ws + WS_BAR), barst);
#define IN(k) (lo <= (k) && (k) < hi)
    if (lo > 1000) grid.sync();
#define SEAM(k) do { if (IN(k) && IN((k) + 1)) xcd_barrier(xbar); } while (0)
    bf16* SEC = (bf16*)(ws + WS_SEC);
    bf16* GATES = (bf16*)args.out;
    float* SS = (float*)(ws + WS_SS);
    if (IN(0)) p0_prologue(F);
    SEAM(0);
    if (IN(1)) {
        if (F.vcu < 192) meta_proj(F, F.vcu);
        pg8::Gemm g{(const bf16*)(ws + WS_HN), (const bf16*)(ws + WS_WIN), MQ, DIN, DM, 0}; pg8::StaticOrder S; S.init(MQ, DIN, F.G, (int)blockIdx.x);
        pg8::EpiProj E{SEC, SEC_ELEMS, GATES, (const float*)(ws + WS_ROPE), F.lds + pg8::EPI_STG_OFF};
        for (int rep = PROBE_P1 ? 0 : 1; rep < 2; ++rep)
        pg8::gemm_phase<pg8::EpiProj, pg8::StaticOrder, true, true>(F.lds, g, S, E);
    }
    SEAM(1);
    if (IN(2)) attn_phase(F);
    SEAM(2);
    if (IN(3)) {
        bf16* TMP = SEC + SEC_ELEMS; bf16* MERGED = SEC + 2 * SEC_ELEMS;
        { pg8::Gemm g{SEC, (const bf16*)(ws + WS_WA), MQ, DM, DM, 1}; pg8::StaticOrder S; S.init(MQ, DM, F.G, (int)blockIdx.x);
          pg8::EpiGate<0> E{GATES, TMP, MERGED, F.lds + pg8::EPI_STG_OFF};
          pg8::gemm_phase<pg8::EpiGate<0>, pg8::StaticOrder, true, true>(F.lds, g, S, E); }
        { pg8::Gemm g{SEC + 3 * SEC_ELEMS, (const bf16*)(ws + WS_WB), MQ, DM, DM, 1}; pg8::StaticOrder S; S.init(MQ, DM, F.G, (int)blockIdx.x);
          pg8::EpiGate<1> E{GATES + (size_t)MQ * 1024, TMP, MERGED, F.lds + pg8::EPI_STG_OFF};
          pg8::gemm_phase<pg8::EpiGate<1>, pg8::StaticOrder, true, true>(F.lds, g, S, E); }
    }
    SEAM(3);
    if (IN(4)) {
        pg8::Gemm g{SEC + 2 * SEC_ELEMS, (const bf16*)(ws + WS_WO), MQ, DM, DM, 0}; pg8::StaticOrder S; S.init(MQ, DM, F.G, (int)blockIdx.x);
        pg8::EpiOut E{F.in[0], args.out, SEC + 4 * SEC_ELEMS, SS, F.lds + pg8::EPI_STG_OFF};
        pg8::gemm_phase<pg8::EpiOut, pg8::StaticOrder, true, true>(F.lds, g, S, E);
    }
    SEAM(4);
    if (IN(5)) {
        { float* R2 = (float*)(ws + WS_R2);
          for (int R = F.vcu * (NWAVES * 64) + F.tid; R < MQ; R += F.G * NWAVES * 64) { const f32x4* sp = (const f32x4*)(SS + (size_t)R * 16); const f32x4 s0 = sp[0], s1 = sp[1], s2 = sp[2], s3 = sp[3];
              const float sq = ((s0[0] + s0[1]) + (s0[2] + s0[3])) + ((s1[0] + s1[1]) + (s1[2] + s1[3])) + ((s2[0] + s2[1]) + (s2[2] + s2[3])) + ((s3[0] + s3[1]) + (s3[2] + s3[3]));
              R2[R] = 1.0f / (sq * (1.0f / 1024.0f) + 1e-6f); } }
        pg8::Gemm g{SEC + 4 * SEC_ELEMS, (const bf16*)(ws + WS_WUP), MQ, FF, DM, 0}; pg8::StaticOrder S; S.init(MQ, FF, F.G, (int)blockIdx.x);
        pg8::EpiUp E{SS, SEC, F.lds + pg8::EPI_STG_OFF};
        pg8::gemm_phase<pg8::EpiUp, pg8::StaticOrder, true, true>(F.lds, g, S, E);
    }
    SEAM(5);
    if (IN(6)) {
        pg8::Gemm g{SEC, (const bf16*)(ws + WS_WDN), MQ, DM, FF, 0}; pg8::StaticOrder S; S.init(MQ, DM, F.G, (int)blockIdx.x);
        pg8::EpiDown E{SEC + 4 * SEC_ELEMS, SEC + 5 * SEC_ELEMS, F.lds + pg8::EPI_STG_OFF, (const float*)(ws + WS_R2)};
        pg8::gemm_phase<pg8::EpiDown, pg8::StaticOrder, true, true>(F.lds, g, S, E);
    }
    SEAM(6);
    if (IN(7)) final_norm(F);
#undef IN
#undef SEAM
}

extern "C" void kernel_launch(void* const* d_in, const int* in_sizes, int n_in, void* d_out, int out_size, void* d_ws, size_t ws_size, hipStream_t stream) {
    static int grid = 0;
    if (grid == 0) {
        if (n_in != 16 || in_sizes[0] != MQ * DM || out_size != MQ * DM || ws_size < WS_END) { fprintf(stderr, "kernel_launch: unexpected shapes (n_in %d in0 %d out %d ws %zu); nothing launched\n", n_in, n_in > 0 ? in_sizes[0] : -1, out_size, ws_size); grid = -1; return; }
        int dev = 0, cus = 0, per_cu = 0;
        (void)hipGetDevice(&dev); (void)hipDeviceGetAttribute(&cus, hipDeviceAttributeMultiprocessorCount, dev);
        if (hipFuncSetAttribute((const void*)mk_fwd, hipFuncAttributeMaxDynamicSharedMemorySize, LDS_BYTES) != hipSuccess) { fprintf(stderr, "kernel_launch: hipFuncSetAttribute failed\n"); grid = -1; return; }
        if (hipOccupancyMaxActiveBlocksPerMultiprocessor(&per_cu, (const void*)mk_fwd, NWAVES * 64, LDS_BYTES) != hipSuccess || per_cu < 1) { fprintf(stderr, "kernel_launch: occupancy query says %d\n", per_cu); per_cu = 1; }
        (void)hipGetLastError();
        grid = cus;
        if (grid <= 0) grid = 256;
    }
    if (grid < 0) return;
    if (hipMemsetAsync((char*)d_ws + WS_BAR, 0, XCD_BAR_WORDS * sizeof(unsigned), stream) != hipSuccess) { fprintf(stderr, "kernel_launch: hipMemsetAsync of the barrier words failed\n"); return; }
    Args a{};
    for (int i = 0; i < 16; ++i) a.in[i] = (const float*)d_in[i];
    a.out = (float*)d_out; a.ws = (unsigned char*)d_ws;
#if MK_MULTI
    for (int p = 0; p < 8; ++p) { a.ph_lo = p; a.ph_hi = p + 1; hipLaunchKernelGGL(mk_fwd, dim3(grid), dim3(NWAVES * 64), LDS_BYTES, stream, a); }
#else
    a.ph_lo = 0; a.ph_hi = 8;
    void* kargs[] = {&a};
    hipError_t e = hipLaunchCooperativeKernel((const void*)mk_fwd, dim3(grid), dim3(NWAVES * 64), kargs, LDS_BYTES, stream);
    if (e != hipSuccess) fprintf(stderr, "kernel_launch: cooperative launch failed: %s (grid %d)\n", hipGetErrorString(e), grid);
#endif
}
```

```cpp
#include <hip/hip_runtime.h>
#include <hip/hip_cooperative_groups.h>
#include <cstdio>
#include <cstdint>
namespace cg = cooperative_groups;
#ifndef PROBE_DIFF
#define PROBE_DIFF 0
#endif
#ifndef PROBE_SB
#define PROBE_SB 0
#endif
#ifndef PROBE_P1
#define PROBE_P1 0
#endif
#ifndef MK_MULTI
#define MK_MULTI 0
#endif
namespace pg8 {
#define PG8_LAS __attribute__((address_space(3)))
typedef unsigned short bf16_t;
typedef short bf16x8 __attribute__((ext_vector_type(8)));
typedef float f32x4 __attribute__((ext_vector_type(4)));
typedef unsigned u32x4 __attribute__((ext_vector_type(4)));
constexpr int BM = 256, BK = 64, HALF = 128, HTB = HALF * BK * 2  , STAGE_BYTES = 8 * HTB, NXCD = 8, WGM = 8;

__host__ __device__ __forceinline__ int lds_byte(int r, int c) { const int st = (r >> 4) * 2 + (c >> 5), rr = r & 15, cc = c & 31, ob = rr * 64 + cc * 2; return st * 1024 + (ob ^ (((ob >> 9) & 1) << 5)); }
__host__ __device__ __forceinline__ void stage_rc(int b, int& R, int& C) { const int st = b / 1024, sb = b % 1024, swz = sb ^ (((sb >> 9) & 1) << 5); R = (st >> 1) * 16 + swz / 64; C = (st & 1) * 32 + (swz % 64) / 2; }
__host__ __device__ __forceinline__ int perm32(int rho) { const int n = rho >> 4, i = rho & 15; return 8 * (i >> 2) + 4 * n + (i & 3); }

struct Unit { int pm, pn; };
struct Gemm { const bf16_t* A; const bf16_t* Bt; int M, N, K; int skip;
    __device__ __forceinline__ const char* a_ptr(int pm) const { return (const char*)A + ((size_t)pm * 256 + (skip ? 16 * ((pm >> 4) + 1) : 0)) * (size_t)K * 2; } };

struct StaticOrder {
    int nM, nN, nwg, G, c;
    __host__ __device__ void init(int M, int N, int G_, int c_) { nM = M / BM; nN = N / BM; nwg = nM * nN; G = G_; c = c_; }
    __host__ __device__ bool next(int i, Unit& u) const {
        const long L = (long)i * G + c; if (L >= nwg) return false;
        int wgid = (int)L; { const int q = nwg / NXCD, r = nwg % NXCD, xcd = wgid % NXCD, off = wgid / NXCD; wgid = (xcd < r ? xcd * (q + 1) : r * (q + 1) + (xcd - r) * q) + off; }
        const int nig = WGM * nN, gid = wgid / nig, fm = gid * WGM, gsz = (nM - fm) < WGM ? (nM - fm) : WGM;
        u.pm = fm + ((wgid % nig) % gsz); u.pn = (wgid % nig) / gsz; return true;
    }
    __device__ __forceinline__ void a_ready(const Unit&) const {}
    __device__ __forceinline__ void done(const Unit&) const {}
};

typedef float f32x2 __attribute__((ext_vector_type(2))); typedef __bf16 bf16x2_t_ __attribute__((ext_vector_type(2)));
__device__ __forceinline__ unsigned cvt_pk_bf16(float lo, float hi) { f32x2 v = {lo, hi}; bf16x2_t_ b = __builtin_convertvector(v, bf16x2_t_); return __builtin_bit_cast(unsigned, b); }

typedef unsigned u32x4 __attribute__((ext_vector_type(4)));
__device__ __forceinline__ float bf_lo(unsigned w) { return __uint_as_float(w << 16); }
__device__ __forceinline__ float bf_hi(unsigned w) { return __uint_as_float(w & 0xffff0000u); }
__device__ __forceinline__ u32x4 pack8(const f32x4& a, const f32x4& b) { u32x4 w; w.x = cvt_pk_bf16(a[0], a[1]); w.y = cvt_pk_bf16(a[2], a[3]); w.z = cvt_pk_bf16(b[0], b[1]); w.w = cvt_pk_bf16(b[2], b[3]); return w; }
__device__ __forceinline__ float sigmoidf_(float x) { return __builtin_amdgcn_rcpf(1.0f + __builtin_amdgcn_exp2f(x * -1.4426950408889634f)); }
constexpr int E_L = 4112, E_MFLAT = 8 * 4112, E_MQ = 8 * 4096;

constexpr int EPI_STG_OFF = 131072 + 1024, EPI_STG_WAVE = 16 * 144;
__device__ __forceinline__ void store_rows16(PG8_LAS unsigned char* stg, bf16_t* gbase, size_t ld, int fr, int fq, const u32x4& w0, const u32x4& w1) {
    *(PG8_LAS u32x4*)(stg + fr * 144 + fq * 16) = w0; *(PG8_LAS u32x4*)(stg + fr * 144 + 64 + fq * 16) = w1;
    const int lane = fr + 16 * fq;
#pragma unroll
    for (int j = 0; j < 2; ++j) { const int c = lane + 64 * j, row = c >> 3, ch = c & 7; const u32x4 v = *(const PG8_LAS u32x4*)(stg + row * 144 + ch * 16); *(u32x4*)(gbase + (size_t)row * ld + ch * 8) = v; }
}
struct EpiProj {
    static constexpr bool PERM = true, AFTER_DRAIN = false;
    bf16_t* P; size_t sec_stride; bf16_t* G; const float* rope; PG8_LAS unsigned char* stg;
    __device__ __forceinline__ void operator()(const f32x4 (&acc)[2][2][4][2], const Unit& u, int wr, int wc, int fr, int fq) const {
        const int sec = u.pn >> 2, colt = (u.pn & 3) * 256;
        const int row0 = u.pm * BM + wr * 64 + fr, col0 = colt + wc * 64 + 8 * fq, colw = colt + wc * 64; PG8_LAS unsigned char* st = stg + (wr * 4 + wc) * EPI_STG_WAVE;
        if (sec < 2) {
            const float sc = sec == 0 ? 0.125f : 1.0f;
#pragma unroll
            for (int ai = 0; ai < 2; ++ai) {
                f32x4 c0[4][2], c1[4][2];
#pragma unroll
                for (int m = 0; m < 4; ++m) { const int Rq = row0 + ai * HALF + m * 16; const int t = (Rq & 4095) + 16;
#pragma unroll
                    for (int bj = 0; bj < 2; ++bj) { const f32x4* rp = (const f32x4*)(rope + ((size_t)t * 32 + 16 * bj + 4 * fq) * 2); c0[m][bj] = rp[0]; c1[m][bj] = rp[1]; } }
#pragma unroll
                for (int m = 0; m < 4; ++m) { const int Rq = row0 + ai * HALF + m * 16; const int R = Rq + 16 * ((Rq >> 12) + 1);
                    u32x4 wv[2];
#pragma unroll
                    for (int bj = 0; bj < 2; ++bj) { const f32x4 v0 = acc[ai][bj][m][0], v1 = acc[ai][bj][m][1]; f32x4 o0, o1;
                        o0[0] = (v0[0] * c0[m][bj][0] - v0[1] * c0[m][bj][1]) * sc; o0[1] = (v0[1] * c0[m][bj][0] + v0[0] * c0[m][bj][1]) * sc;
                        o0[2] = (v0[2] * c0[m][bj][2] - v0[3] * c0[m][bj][3]) * sc; o0[3] = (v0[3] * c0[m][bj][2] + v0[2] * c0[m][bj][3]) * sc;
                        o1[0] = (v1[0] * c1[m][bj][0] - v1[1] * c1[m][bj][1]) * sc; o1[1] = (v1[1] * c1[m][bj][0] + v1[0] * c1[m][bj][1]) * sc;
                        o1[2] = (v1[2] * c1[m][bj][2] - v1[3] * c1[m][bj][3]) * sc; o1[3] = (v1[3] * c1[m][bj][2] + v1[2] * c1[m][bj][3]) * sc;
                        wv[bj] = pack8(o0, o1); }
                    store_rows16(st, P + (size_t)sec * sec_stride + (size_t)(R - fr) * 1024 + colw, 1024, fr, fq, wv[0], wv[1]); }
            }
        } else if (sec < 6) {
            const float sc = sec == 3 ? 0.125f * 1.4426950408889634f : 1.0f;
#pragma unroll
            for (int ai = 0; ai < 2; ++ai)
#pragma unroll
                for (int m = 0; m < 4; ++m) { const int Rq = row0 + ai * HALF + m * 16; const int R = Rq + 16 * ((Rq >> 12) + 1);
                    u32x4 wv[2];
#pragma unroll
                    for (int bj = 0; bj < 2; ++bj) { const f32x4 v0 = acc[ai][bj][m][0] * sc, v1 = acc[ai][bj][m][1] * sc; wv[bj] = pack8(v0, v1); }
                    store_rows16(st, P + (size_t)sec * sec_stride + (size_t)(R - fr) * 1024 + colw, 1024, fr, fq, wv[0], wv[1]); }
        } else {
#pragma unroll
            for (int ai = 0; ai < 2; ++ai)
#pragma unroll
                for (int m = 0; m < 4; ++m) { const int Rq = row0 + ai * HALF + m * 16;
                    u32x4 wv[2];
#pragma unroll
                    for (int bj = 0; bj < 2; ++bj) { const f32x4 v0 = acc[ai][bj][m][0], v1 = acc[ai][bj][m][1]; f32x4 o0, o1;
#pragma unroll
                        for (int e = 0; e < 4; ++e) { o0[e] = sigmoidf_(v0[e]); o1[e] = sigmoidf_(v1[e]); }
                        wv[bj] = pack8(o0, o1); }
                    store_rows16(st, G + (size_t)(sec - 6) * ((size_t)E_MQ * 1024) + (size_t)(Rq - fr) * 1024 + colw, 1024, fr, fq, wv[0], wv[1]); }
        }
    }
};
template <int WHICH> struct EpiGate {
    static constexpr bool PERM = true, AFTER_DRAIN = false;
    const bf16_t* G; bf16_t* T; bf16_t* O; PG8_LAS unsigned char* stg;
    __device__ __forceinline__ void operator()(const f32x4 (&acc)[2][2][4][2], const Unit& u, int wr, int wc, int fr, int fq) const {
        const int row0 = u.pm * BM + wr * 64 + fr, col0 = u.pn * BM + wc * 64 + 8 * fq;
#pragma unroll
        for (int ai = 0; ai < 2; ++ai) {
            u32x4 gv[4][2], tv[4][2];
#pragma unroll
            for (int m = 0; m < 4; ++m) { const size_t off = (size_t)(row0 + ai * HALF + m * 16) * 1024 + col0;
#pragma unroll
                for (int bj = 0; bj < 2; ++bj) { gv[m][bj] = *(const u32x4*)(G + off + bj * 32); if (WHICH == 1) tv[m][bj] = *(const u32x4*)(T + off + bj * 32); } }
#pragma unroll
            for (int m = 0; m < 4; ++m) { const size_t off = (size_t)(row0 + ai * HALF + m * 16) * 1024 + col0;
                u32x4 wv[2];
#pragma unroll
                for (int bj = 0; bj < 2; ++bj) { const u32x4 g = gv[m][bj]; const f32x4 v0 = acc[ai][bj][m][0], v1 = acc[ai][bj][m][1]; f32x4 o0, o1;
                    o0[0] = v0[0] * bf_lo(g.x); o0[1] = v0[1] * bf_hi(g.x); o0[2] = v0[2] * bf_lo(g.y); o0[3] = v0[3] * bf_hi(g.y);
                    o1[0] = v1[0] * bf_lo(g.z); o1[1] = v1[1] * bf_hi(g.z); o1[2] = v1[2] * bf_lo(g.w); o1[3] = v1[3] * bf_hi(g.w);
                    if (WHICH == 1) { const u32x4 t = tv[m][bj];
                        o0[0] += bf_lo(t.x); o0[1] += bf_hi(t.x); o0[2] += bf_lo(t.y); o0[3] += bf_hi(t.y);
                        o1[0] += bf_lo(t.z); o1[1] += bf_hi(t.z); o1[2] += bf_lo(t.w); o1[3] += bf_hi(t.w); }
                    wv[bj] = pack8(o0, o1); }
                store_rows16(stg + (wr * 4 + wc) * EPI_STG_WAVE, (WHICH == 0 ? T : O) + off - (size_t)fr * 1024 - 8 * fq, 1024, fr, fq, wv[0], wv[1]); }
        }
    }
};
struct EpiOut {
    static constexpr bool PERM = true, AFTER_DRAIN = false;
    const float* x; float* h2; bf16_t* h2b; float* ss; PG8_LAS unsigned char* stg;
    __device__ __forceinline__ void operator()(const f32x4 (&acc)[2][2][4][2], const Unit& u, int wr, int wc, int fr, int fq) const {
        const int row0 = u.pm * BM + wr * 64 + fr, col0 = u.pn * BM + wc * 64 + 8 * fq;
#pragma unroll
        for (int ai = 0; ai < 2; ++ai) {
            f32x4 xa[4][2], xb[4][2];
#pragma unroll
            for (int m = 0; m < 4; ++m) { const size_t off = (size_t)(row0 + ai * HALF + m * 16) * 1024 + col0;
#pragma unroll
                for (int bj = 0; bj < 2; ++bj) { xa[m][bj] = *(const f32x4*)(x + off + bj * 32); xb[m][bj] = *(const f32x4*)(x + off + bj * 32 + 4); } }
#pragma unroll
            for (int m = 0; m < 4; ++m) { const int R = row0 + ai * HALF + m * 16; const size_t off = (size_t)R * 1024 + col0; float q = 0.f;
                u32x4 wv[2];
#pragma unroll
                for (int bj = 0; bj < 2; ++bj) { const f32x4 o0 = xa[m][bj] + acc[ai][bj][m][0], o1 = xb[m][bj] + acc[ai][bj][m][1];
                    wv[bj] = pack8(o0, o1);
                    q += (o0[0] * o0[0] + o0[1] * o0[1]) + (o0[2] * o0[2] + o0[3] * o0[3]) + (o1[0] * o1[0] + o1[1] * o1[1]) + (o1[2] * o1[2] + o1[3] * o1[3]); }
                store_rows16(stg + (wr * 4 + wc) * EPI_STG_WAVE, h2b + off - (size_t)fr * 1024 - 8 * fq, 1024, fr, fq, wv[0], wv[1]);
                q += __shfl_xor(q, 16); q += __shfl_xor(q, 32);
                if (fq == 0) ss[(size_t)R * 16 + u.pn * 4 + wc] = q; }
        }
    }
};
struct EpiUp {
    static constexpr bool PERM = true, AFTER_DRAIN = false;
    const float* ss; bf16_t* U; PG8_LAS unsigned char* stg;
    __device__ __forceinline__ void operator()(const f32x4 (&acc)[2][2][4][2], const Unit& u, int wr, int wc, int fr, int fq) const {
        const int row0 = u.pm * BM + wr * 64 + fr, col0 = u.pn * BM + wc * 64 + 8 * fq;
#pragma unroll
        for (int ai = 0; ai < 2; ++ai)
#pragma unroll
            for (int m = 0; m < 4; ++m) { const int R = row0 + ai * HALF + m * 16;
                u32x4 wv[2];
#pragma unroll
                for (int bj = 0; bj < 2; ++bj) { f32x4 v0 = acc[ai][bj][m][0], v1 = acc[ai][bj][m][1];
#pragma unroll
                    for (int e = 0; e < 4; ++e) { const float a = fmaxf(v0[e], 0.f), b = fmaxf(v1[e], 0.f); v0[e] = a * a; v1[e] = b * b; }
                    wv[bj] = pack8(v0, v1); }
                store_rows16(stg + (wr * 4 + wc) * EPI_STG_WAVE, U + (size_t)(R - fr) * 4096 + col0 - 8 * fq, 4096, fr, fq, wv[0], wv[1]); }
    }
};
struct EpiDown {
    static constexpr bool PERM = true, AFTER_DRAIN = false;
    const bf16_t* h2b; bf16_t* h; PG8_LAS unsigned char* stg; const float* r2a;
    __device__ __forceinline__ void operator()(const f32x4 (&acc)[2][2][4][2], const Unit& u, int wr, int wc, int fr, int fq) const {
        const int row0 = u.pm * BM + wr * 64 + fr, col0 = u.pn * BM + wc * 64 + 8 * fq;
#pragma unroll
        for (int ai = 0; ai < 2; ++ai) {
            u32x4 rv[4][2]; float r2v[4];
#pragma unroll
            for (int m = 0; m < 4; ++m) { const int R = row0 + ai * HALF + m * 16; const size_t off = (size_t)R * 1024 + col0; r2v[m] = r2a[R];
#pragma unroll
                for (int bj = 0; bj < 2; ++bj) rv[m][bj] = *(const u32x4*)(h2b + off + bj * 32); }
#pragma unroll
            for (int m = 0; m < 4; ++m) { const size_t off = (size_t)(row0 + ai * HALF + m * 16) * 1024 + col0; const float r2 = r2v[m];
                u32x4 wv[2];
#pragma unroll
                for (int bj = 0; bj < 2; ++bj) { const u32x4 r = rv[m][bj];
                    const f32x4 a = {bf_lo(r.x), bf_hi(r.x), bf_lo(r.y), bf_hi(r.y)}, b = {bf_lo(r.z), bf_hi(r.z), bf_lo(r.w), bf_hi(r.w)};
                    wv[bj] = pack8(a + acc[ai][bj][m][0] * r2, b + acc[ai][bj][m][1] * r2); }
                store_rows16(stg + (wr * 4 + wc) * EPI_STG_WAVE, h + off - (size_t)fr * 1024 - 8 * fq, 1024, fr, fq, wv[0], wv[1]); }
        }
    }
};

template <class Epi, class Sched, bool ALIGN_EPI = false, bool SP2 = false>
__device__ __forceinline__ void gemm_phase(PG8_LAS unsigned char* lds, const Gemm g, const Sched& S, const Epi& E) {
    const int tid = threadIdx.x, wid = __builtin_amdgcn_readfirstlane(tid >> 6), lane = tid & 63, wr = wid >> 2, wc = wid & 3, fr = lane & 15, fq = lane >> 4;
    const int K = g.K, nt = K / BK;
    unsigned voffA[2], voffB[2];
#pragma unroll
    for (int i = 0; i < 2; ++i) { int R, C; stage_rc(tid * 16 + i * 8192, R, C); const int Rb = Epi::PERM ? (64 * (R >> 5) + perm32(R & 31)) : R;
        voffA[i] = (unsigned)(R * K + C) * 2u; voffB[i] = (unsigned)(Rb * K + C) * 2u; }
    const size_t kstep = (size_t)(BK * 2);
    const size_t hstep = (size_t)HALF * K * 2;
    const size_t tstep = 2 * hstep;
    const size_t hstepB = Epi::PERM ? (size_t)32 * K * 2 : hstep;
    const unsigned ldsw = (unsigned)wid * 1024u;
    const int aoff = lds_byte(wr * 64 + fr, fq * 8), boff = lds_byte(wc * 32 + fr, fq * 8);
#define PG8_SA(b, h) (((b) * 2 + (h)) * HTB)
#define PG8_SB(b, h) ((4 + (b) * 2 + (h)) * HTB)
#define PG8_STAGE(bufoff, gbase, voff) do { _Pragma("unroll") for (int _i = 0; _i < 2; ++_i) \
        __builtin_amdgcn_global_load_lds((const unsigned*)((const char*)(gbase) + (voff)[_i]), (PG8_LAS unsigned*)(lds + (bufoff) + ldsw + _i * 8192), 16, 0, 0); } while (0)
#define PG8_LDA(dst, b, h) do { _Pragma("unroll") for (int m = 0; m < 4; ++m) _Pragma("unroll") for (int k = 0; k < 2; ++k) dst[m][k] = *(const PG8_LAS bf16x8*)(lds + PG8_SA(b, h) + aoff + m * 2048 + k * 1024); } while (0)
#define PG8_LDB(dst, b, h) do { _Pragma("unroll") for (int n = 0; n < 2; ++n) _Pragma("unroll") for (int k = 0; k < 2; ++k) dst[n][k] = *(const PG8_LAS bf16x8*)(lds + PG8_SB(b, h) + boff + n * 2048 + k * 1024); } while (0)
#define PG8_MMA(ai, bj, At, Bt) do { __builtin_amdgcn_s_setprio(1); _Pragma("unroll") for (int m = 0; m < 4; ++m) _Pragma("unroll") for (int n = 0; n < 2; ++n) _Pragma("unroll") for (int k = 0; k < 2; ++k) \
        acc[ai][bj][m][n] = __builtin_amdgcn_mfma_f32_16x16x32_bf16(Bt[n][k], At[m][k], acc[ai][bj][m][n], 0, 0, 0); __builtin_amdgcn_s_setprio(0); } while (0)
#define PG8_WAIT_V(n) asm volatile("s_waitcnt vmcnt(" #n ")" ::: "memory")
#define PG8_WAIT_L(n) asm volatile("s_waitcnt lgkmcnt(" #n ")" ::: "memory")
#define PG8_BAR __builtin_amdgcn_s_barrier()
#define PG8_SCHED __builtin_amdgcn_sched_barrier(0)
    Unit cur, nxt; int ui = 0;
    if (!S.next(0, cur)) return;
    f32x4 acc[2][2][4][2];
#pragma unroll
    for (int a = 0; a < 2; ++a)
#pragma unroll
        for (int b = 0; b < 2; ++b)
#pragma unroll
            for (int m = 0; m < 4; ++m)
#pragma unroll
                for (int n = 0; n < 2; ++n) acc[a][b][m][n] = (f32x4){0.f, 0.f, 0.f, 0.f};
    bf16x8 At[4][2], B0[2][2], B1[2][2];
    const char* cA = g.a_ptr(cur.pm); const char* cB = (const char*)g.Bt + (size_t)cur.pn * tstep;
    S.a_ready(cur);
    if constexpr (SP2) {
        PG8_STAGE(PG8_SB(0, 0), cB, voffB); PG8_STAGE(PG8_SB(0, 1), cB + hstepB, voffB); PG8_STAGE(PG8_SA(0, 0), cA, voffA); PG8_STAGE(PG8_SA(0, 1), cA + hstep, voffA);
        if (wr == 1) PG8_BAR;
        PG8_WAIT_V(2); PG8_BAR;
        PG8_STAGE(PG8_SB(1, 0), cB + kstep, voffB); PG8_STAGE(PG8_SA(1, 0), cA + kstep, voffA); PG8_STAGE(PG8_SB(1, 1), cB + hstepB + kstep, voffB);
        PG8_WAIT_V(6); PG8_BAR;
    } else {
        PG8_STAGE(PG8_SB(0, 0), cB, voffB); PG8_STAGE(PG8_SA(0, 0), cA, voffA); PG8_STAGE(PG8_SB(0, 1), cB + hstepB, voffB); PG8_STAGE(PG8_SA(0, 1), cA + hstep, voffA);
        if (wr == 1) PG8_BAR;
        PG8_WAIT_V(4); PG8_BAR;
        PG8_STAGE(PG8_SB(1, 0), cB + kstep, voffB); PG8_STAGE(PG8_SA(1, 0), cA + kstep, voffA); PG8_STAGE(PG8_SB(1, 1), cB + hstepB + kstep, voffB);
        PG8_WAIT_V(6); PG8_BAR;
    }
    for (;;) {
        const bool has_next = S.next(ui + 1, nxt);
        const char* nA = has_next ? g.a_ptr(nxt.pm) : cA; const char* nB = has_next ? (const char*)g.Bt + (size_t)nxt.pn * tstep : cB;
        for (int t = 0; t < nt; t += 2) {
            const bool last = (t == nt - 2);
            const char* a1 = cA + (size_t)(t + 1) * kstep;
            const char* a2 = last ? nA : cA + (size_t)(t + 2) * kstep; const char* b2 = last ? nB : cB + (size_t)(t + 2) * kstep;
            const char* a3 = a2 + kstep; const char* b3 = b2 + kstep;
            if (last && has_next) S.a_ready(nxt);
            if constexpr (SP2) {
            PG8_LDB(B0, 0, 0); PG8_LDB(B1, 0, 1); PG8_SCHED; PG8_LDA(At, 0, 0); PG8_STAGE(PG8_SA(1, 1), a1 + hstep, voffA);
            PG8_WAIT_V(8); PG8_WAIT_L(0); PG8_BAR; PG8_MMA(0, 0, At, B0); PG8_MMA(0, 1, At, B1); PG8_BAR; PG8_SCHED;
            PG8_LDA(At, 0, 1); PG8_STAGE(PG8_SB(0, 0), b2, voffB); PG8_STAGE(PG8_SB(0, 1), b2 + hstepB, voffB); PG8_STAGE(PG8_SA(0, 0), a2, voffA);
            PG8_WAIT_V(8); PG8_WAIT_L(0); PG8_BAR; PG8_MMA(1, 0, At, B0); PG8_MMA(1, 1, At, B1); PG8_BAR; PG8_SCHED;
            PG8_LDB(B0, 1, 0); PG8_LDB(B1, 1, 1); PG8_SCHED; PG8_LDA(At, 1, 0); PG8_STAGE(PG8_SA(0, 1), a2 + hstep, voffA);
            PG8_WAIT_V(8); PG8_WAIT_L(0); PG8_BAR; PG8_MMA(0, 0, At, B0); PG8_MMA(0, 1, At, B1); PG8_BAR; PG8_SCHED;
            PG8_LDA(At, 1, 1); PG8_STAGE(PG8_SB(1, 0), b3, voffB); PG8_STAGE(PG8_SB(1, 1), b3 + hstepB, voffB); PG8_STAGE(PG8_SA(1, 0), a3, voffA);
            PG8_WAIT_V(8); PG8_WAIT_L(0); PG8_BAR; PG8_MMA(1, 0, At, B0); PG8_MMA(1, 1, At, B1); PG8_BAR; PG8_SCHED;
            } else {
            PG8_LDB(B0, 0, 0); PG8_SCHED; PG8_LDA(At, 0, 0); PG8_STAGE(PG8_SA(1, 1), a1 + hstep, voffA);
            PG8_WAIT_L(8); PG8_BAR; PG8_WAIT_L(0); PG8_MMA(0, 0, At, B0); PG8_BAR; PG8_SCHED;
            PG8_LDB(B1, 0, 1); PG8_STAGE(PG8_SB(0, 0), b2, voffB);
            PG8_BAR; PG8_WAIT_L(0); PG8_MMA(0, 1, At, B1); PG8_BAR;
            PG8_LDA(At, 0, 1); PG8_STAGE(PG8_SA(0, 0), a2, voffA);
            PG8_BAR; PG8_WAIT_L(0); PG8_MMA(1, 0, At, B0); PG8_BAR; PG8_SCHED;
            PG8_STAGE(PG8_SB(0, 1), b2 + hstepB, voffB);
            PG8_WAIT_V(6); PG8_BAR; PG8_MMA(1, 1, At, B1); PG8_BAR;
            PG8_LDB(B0, 1, 0); PG8_SCHED; PG8_LDA(At, 1, 0); PG8_STAGE(PG8_SA(0, 1), a2 + hstep, voffA);
            PG8_WAIT_L(8); PG8_BAR; PG8_WAIT_L(0); PG8_MMA(0, 0, At, B0); PG8_BAR; PG8_SCHED;
            PG8_LDB(B1, 1, 1); PG8_STAGE(PG8_SB(1, 0), b3, voffB);
            PG8_BAR; PG8_WAIT_L(0); PG8_MMA(0, 1, At, B1); PG8_BAR;
            PG8_LDA(At, 1, 1); PG8_STAGE(PG8_SA(1, 0), a3, voffA);
            PG8_BAR; PG8_WAIT_L(0); PG8_MMA(1, 0, At, B0); PG8_BAR; PG8_SCHED;
            PG8_STAGE(PG8_SB(1, 1), b3 + hstepB, voffB);
            PG8_WAIT_V(6); PG8_BAR; PG8_MMA(1, 1, At, B1); PG8_BAR;
            }
        }
        if constexpr (ALIGN_EPI) { if (wr == 0) PG8_BAR; }
        if constexpr (!Epi::AFTER_DRAIN) { E(acc, cur, wr, wc, fr, fq); S.done(cur); }
        if (!has_next) break;
#pragma unroll
        for (int a = 0; a < 2; ++a)
#pragma unroll
            for (int b = 0; b < 2; ++b)
#pragma unroll
                for (int m = 0; m < 4; ++m)
#pragma unroll
                    for (int n = 0; n < 2; ++n) acc[a][b][m][n] = (f32x4){0.f, 0.f, 0.f, 0.f};
        cur = nxt; cA = nA; cB = nB; ++ui;
        if constexpr (ALIGN_EPI) { if (wr == 1) PG8_BAR; }
    }
    PG8_WAIT_V(0);
    if constexpr (!ALIGN_EPI) { if (wr == 0) PG8_BAR; }
    PG8_BAR;
    if constexpr (Epi::AFTER_DRAIN) { E.fused(acc, cur, wr, wc, fr, fq, lds, wid, lane); S.done(cur); }
#undef PG8_SA
#undef PG8_SB
#undef PG8_STAGE
#undef PG8_LDA
#undef PG8_LDB
#undef PG8_MMA
#undef PG8_WAIT_V
#undef PG8_WAIT_L
#undef PG8_BAR
#undef PG8_SCHED
}
}

#define LAS __attribute__((address_space(3)))
typedef unsigned short bf16;
typedef short bf16x8 __attribute__((ext_vector_type(8)));
typedef short s16x4 __attribute__((ext_vector_type(4)));
typedef float f32x4 __attribute__((ext_vector_type(4)));
typedef float f32x16 __attribute__((ext_vector_type(16)));
typedef unsigned u32x4 __attribute__((ext_vector_type(4)));
typedef unsigned u32x2 __attribute__((ext_vector_type(2)));
constexpr int NWAVES = 8;
constexpr int BATCH = 8, SEQ = 4096, NMETA = 16, LT = 4112, DM = 1024, DIN = 8192, FF = 4096;
constexpr int MFLAT = BATCH * LT, MP = 33024, MQ = BATCH * SEQ;
constexpr size_t MiB = 1u << 20;
constexpr size_t WS_SS = 0, WS_ROPE = 4 * MiB, WS_WIN = 6 * MiB, WS_WA = 22 * MiB, WS_WB = 24 * MiB, WS_WO = 26 * MiB, WS_WUP = 28 * MiB, WS_WDN = 36 * MiB;
constexpr size_t WS_SEC = 44 * MiB, SEC_BYTES = 65 * MiB, SEC_ELEMS = SEC_BYTES / 2;
constexpr size_t WS_HN = WS_SEC + 6 * SEC_BYTES, WS_END = WS_HN + 65 * MiB;
static_assert((size_t)MP * 1024 * 2 <= SEC_BYTES && (size_t)MQ * 4096 * 2 <= 4 * SEC_BYTES, "ws map");
constexpr size_t WS_R2 = 2 * MiB;
constexpr size_t WS_HNM = 5 * MiB + 256 * 1024;
constexpr size_t WS_BAR = 5 * MiB + 512 * 1024;
constexpr int LDS_BYTES = 131072 + 1024 + 8 * 16 * 144, LDS_BARW = 131072 + 512;
constexpr float LOG2E = 1.4426950408889634f, LN2 = 0.6931471805599453f, EPS = 1e-6f;

struct Frame {
    LAS unsigned char* lds; int tid, lane, wave, vcu, G;
    const float* in[16]; float* out; unsigned char* ws;
};
__device__ __forceinline__ float wave_sum(float v) {
#pragma unroll
    for (int o = 1; o < 64; o <<= 1) v += __shfl_xor(v, o);
    return v;
}
__device__ __forceinline__ unsigned cvtpk(float lo, float hi) { return pg8::cvt_pk_bf16(lo, hi); }

template <bool ROPEPERM> __device__ __forceinline__ void p0_transpose_item(const float* W, int K, int N, bf16* WT, const float* gk, LAS float* scr, int item, int lane) {
    const int nblk = N / 32, kb = item / nblk, nb = item % nblk, k0 = 64 * kb, n0 = 32 * nb;
    int src = n0 + (lane & 31);
    if (ROPEPERM && src < 2048) { const int w = src & 63; src = (src & ~63) + (w >> 1) + 32 * (w & 1); }
    float wv_[32];
#pragma unroll
    for (int i = 0; i < 32; ++i) { const int kk = 2 * i + (lane >> 5); wv_[i] = W[(size_t)(k0 + kk) * N + src]; }
#pragma unroll
    for (int i = 0; i < 32; ++i) { const int kk = 2 * i + (lane >> 5); float v = wv_[i]; if (gk) v *= gk[k0 + kk]; scr[kk * 33 + (lane & 31)] = v; }
    asm volatile("s_waitcnt lgkmcnt(0)" ::: "memory");
    const int c = lane & 7;
#pragma unroll
    for (int j = 0; j < 4; ++j) { const int n = (lane >> 3) + 8 * j; const LAS float* s = scr + (8 * c) * 33 + n;
        u32x4 o; o.x = cvtpk(s[0 * 33], s[1 * 33]); o.y = cvtpk(s[2 * 33], s[3 * 33]); o.z = cvtpk(s[4 * 33], s[5 * 33]); o.w = cvtpk(s[6 * 33], s[7 * 33]);
        *(u32x4*)(WT + (size_t)(n0 + n) * K + k0 + 8 * c) = o; }
    asm volatile("s_waitcnt lgkmcnt(0)" ::: "memory");
}
__device__ __forceinline__ void p0_prologue(const Frame& F) {
    LAS float* scr = (LAS float*)(F.lds + F.wave * 16384);
    const int gw = F.vcu * NWAVES + F.wave, NGW = F.G * NWAVES;
    unsigned char* ws = F.ws;
    constexpr int I_IN = 16 * 256, I_SQ = 16 * 32, I_UP = 16 * 128, I_DN = 64 * 32, NITEMS = I_IN + 3 * I_SQ + I_UP + I_DN;
    for (int it = gw; it < NITEMS; it += NGW) {
        int r = it;
        if (r < I_IN) { p0_transpose_item<true>(F.in[3], DM, DIN, (bf16*)(ws + WS_WIN), nullptr, scr, r, F.lane); continue; } r -= I_IN;
        if (r < I_SQ) { p0_transpose_item<false>(F.in[9], DM, DM, (bf16*)(ws + WS_WA), nullptr, scr, r, F.lane); continue; } r -= I_SQ;
        if (r < I_SQ) { p0_transpose_item<false>(F.in[10], DM, DM, (bf16*)(ws + WS_WB), nullptr, scr, r, F.lane); continue; } r -= I_SQ;
        if (r < I_SQ) { p0_transpose_item<false>(F.in[11], DM, DM, (bf16*)(ws + WS_WO), nullptr, scr, r, F.lane); continue; } r -= I_SQ;
        if (r < I_UP) { p0_transpose_item<false>(F.in[13], DM, FF, (bf16*)(ws + WS_WUP), F.in[12], scr, r, F.lane); continue; } r -= I_UP;
        p0_transpose_item<false>(F.in[14], FF, DM, (bf16*)(ws + WS_WDN), nullptr, scr, r, F.lane);
    }
    bf16* HN = (bf16*)(ws + WS_HN); bf16* HNM = (bf16*)(ws + WS_HNM);
    const f32x4* g4 = (const f32x4*)F.in[2] + F.lane;
    constexpr int NR = 4;
    for (int R0 = gw; R0 < MQ + NMETA; R0 += NR * NGW) {
        f32x4 v[NR][4]; float sq[NR]; bool has[NR]; int Rr[NR];
#pragma unroll
        for (int rr = 0; rr < NR; ++rr) { const int R = R0 + rr * NGW; has[rr] = R < MQ + NMETA; Rr[rr] = has[rr] ? R : R0;
            const f32x4* xr = (const f32x4*)(Rr[rr] < MQ ? F.in[0] + (size_t)Rr[rr] * DM : F.in[1] + (size_t)(Rr[rr] - MQ) * DM) + F.lane;
#pragma unroll
            for (int j = 0; j < 4; ++j) v[rr][j] = xr[64 * j]; }
#pragma unroll
        for (int rr = 0; rr < NR; ++rr) { float s = 0.f;
#pragma unroll
            for (int j = 0; j < 4; ++j) s += (v[rr][j].x * v[rr][j].x + v[rr][j].y * v[rr][j].y) + (v[rr][j].z * v[rr][j].z + v[rr][j].w * v[rr][j].w);
            sq[rr] = s; }
#pragma unroll
        for (int rr = 0; rr < NR; ++rr) { const float rstd = 1.0f / sqrtf(wave_sum(sq[rr]) * (1.0f / DM) + EPS);
            u32x2* o8 = (u32x2*)(Rr[rr] < MQ ? HN + (size_t)Rr[rr] * DM : HNM + (size_t)(Rr[rr] - MQ) * DM) + F.lane;
            if (has[rr]) {
#pragma unroll
                for (int j = 0; j < 4; ++j) { const f32x4 g = g4[64 * j]; o8[64 * j] = (u32x2){cvtpk(v[rr][j].x * rstd * g.x, v[rr][j].y * rstd * g.y), cvtpk(v[rr][j].z * rstd * g.z, v[rr][j].w * rstd * g.w)}; } } }
    }
    float* rope = (float*)(ws + WS_ROPE);
    for (int idx = (F.vcu * NWAVES * 64) + F.tid; idx < LT * 32; idx += F.G * NWAVES * 64) {
        const int pos = idx >> 5, i = idx & 31;
        const float inv = (float)exp(-(double)i * (9.210340371976184 / 32.0));
        const float ang = (float)pos * inv;
        const double a = (double)ang; const double k = rint(a * 0.15915494309189535); const double rr = fma(-k, 6.283185307179586, a) - k * 2.4492935982947064e-16;
        const float rf = (float)rr;
        rope[2 * idx] = cosf(rf); rope[2 * idx + 1] = sinf(rf);
    }
}

__device__ __forceinline__ int crow(int r, int hi) { return (r & 3) + 8 * (r >> 2) + 4 * hi; }
typedef short v4i16_t __attribute__((ext_vector_type(4)));
__device__ __forceinline__ s16x4 vtr(const LAS unsigned char* p) { return __builtin_bit_cast(s16x4, __builtin_amdgcn_ds_read_tr16_b64_v4i16((LAS v4i16_t*)p)); }
#define MFMA32(a, b, c) __builtin_amdgcn_mfma_f32_32x32x16_bf16((a), (b), (c), 0, 0, 0)
__device__ __forceinline__ bf16x8 pack_step(const f32x16& x, int s) {
    u32x4 p; p.x = cvtpk(x[8 * s], x[8 * s + 1]); p.y = cvtpk(x[8 * s + 2], x[8 * s + 3]); p.z = cvtpk(x[8 * s + 4], x[8 * s + 5]); p.w = cvtpk(x[8 * s + 6], x[8 * s + 7]);
    return __builtin_bit_cast(bf16x8, p);
}
#define VFRAG(ptr, off0, STR) ({ const s16x4 lo_ = vtr((ptr) + (off0)); const s16x4 hi_ = vtr((ptr) + (off0) + 8 * (STR)); (bf16x8){lo_[0], lo_[1], lo_[2], lo_[3], hi_[0], hi_[1], hi_[2], hi_[3]}; })

constexpr int DK_STR = 272, DV_STR = 320, DK_BUF = 64 * DK_STR, DV_BUF = 64 * DV_STR, D_KOFF = 0, D_VOFF = 2 * DK_BUF;
__device__ __forceinline__ void diff_unit(const Frame& F, int b, int h, int qi, float lam, int dry) {
    LAS unsigned char* lds = F.lds;
    const int tid = F.tid, lane = F.lane, wid = F.wave, r32 = lane & 31, hi = lane >> 5;
    const int map = wid >> 2, wq = wid & 3;
    const size_t rowbase = (size_t)b * LT;
    const int tq0 = NMETA + 128 * qi, tqw = tq0 + 32 * wq, tq = tqw + r32;
    bf16* QA = (bf16*)(F.ws + WS_SEC); const bf16* KA = QA + SEC_ELEMS; const bf16* VA = QA + 2 * SEC_ELEMS;
    bf16x8 qf[4];
    { const bf16* qp = QA + (rowbase + tq) * 1024 + 128 * h + 64 * map + 8 * hi;
#pragma unroll
      for (int ks = 0; ks < 4; ++ks) qf[ks] = *(const bf16x8*)(qp + 16 * ks); }
    const int srow = tid >> 4, sc16 = tid & 15;
    const bf16* kg = KA + (rowbase + srow) * 1024 + 128 * h + sc16 * 8;
    const bf16* vg = VA + (rowbase + srow) * 1024 + 128 * h + sc16 * 8;
    const int klds = D_KOFF + srow * DK_STR + sc16 * 16, vlds = D_VOFF + srow * DV_STR + sc16 * 16;
    u32x4 st0, st1, st2, st3;
#define D_LOAD(key0) do { st0 = *(const u32x4*)(kg + (size_t)(key0) * 1024); st1 = *(const u32x4*)(kg + (size_t)((key0) + 32) * 1024); st2 = *(const u32x4*)(vg + (size_t)(key0) * 1024); st3 = *(const u32x4*)(vg + (size_t)((key0) + 32) * 1024); } while (0)
#define D_STORE(buf) do { *(LAS u32x4*)(lds + klds + (buf) * DK_BUF) = st0; *(LAS u32x4*)(lds + klds + (buf) * DK_BUF + 32 * DK_STR) = st1; *(LAS u32x4*)(lds + vlds + (buf) * DV_BUF) = st2; *(LAS u32x4*)(lds + vlds + (buf) * DV_BUF + 32 * DV_STR) = st3; } while (0)
    const int nt = 2 * qi + 3;
    __syncthreads();
    D_LOAD(0); D_STORE(0);
    __syncthreads();
    f32x16 O[4];
#pragma unroll
    for (int dt = 0; dt < 4; ++dt)
#pragma unroll
        for (int r = 0; r < 16; ++r) O[dt][r] = 0.f;
    float ms = -INFINITY, lsum = 0.f;
    const int kra = D_KOFF + r32 * DK_STR + map * 128 + hi * 16;
    const int vra = D_VOFF + (4 * hi + ((lane & 15) >> 2)) * DV_STR + (16 * ((lane >> 4) & 1) + 4 * (lane & 3)) * 2;
    for (int it = 0; it < nt; ++it) {
        const int key0 = it == 0 ? 0 : NMETA + 64 * (it - 1);
        if (it + 1 < nt) D_LOAD(NMETA + 64 * it);
        const bool meta = (it == 0);
        if (meta || key0 <= tqw + 31) {
            const LAS unsigned char* kb = lds + kra + (it & 1) * DK_BUF;
            const LAS unsigned char* vb = lds + vra + (it & 1) * DV_BUF;
            f32x16 s0, s1;
#pragma unroll
            for (int r = 0; r < 16; ++r) { s0[r] = 0.f; s1[r] = 0.f; }
            bf16x8 vpre0 = VFRAG(vb, 0, DV_STR), vpre1 = VFRAG(vb, 64, DV_STR), vpre2 = VFRAG(vb, 128, DV_STR), vpre3 = VFRAG(vb, 192, DV_STR);
            bf16x8 vprf0 = VFRAG(vb, 16 * DV_STR, DV_STR), vprf1 = VFRAG(vb, 16 * DV_STR + 64, DV_STR);
            __builtin_amdgcn_s_setprio(1);
#pragma unroll
            for (int ks = 0; ks < 4; ++ks) { const bf16x8 k0 = *(const LAS bf16x8*)(kb + ks * 32); s0 = MFMA32(k0, qf[ks], s0); }
            if (!meta) {
#pragma unroll
                for (int ks = 0; ks < 4; ++ks) { const bf16x8 k1 = *(const LAS bf16x8*)(kb + 32 * DK_STR + ks * 32); s1 = MFMA32(k1, qf[ks], s1); }
            }
            __builtin_amdgcn_s_setprio(0);
            if (meta) {
#pragma unroll
                for (int r = 8; r < 16; ++r) s0[r] = -INFINITY;
#pragma unroll
                for (int r = 0; r < 16; ++r) s1[r] = -INFINITY;
            } else if (key0 + 63 > tqw) {
#pragma unroll
                for (int r = 0; r < 16; ++r) { const int c = (r & 3) + 8 * (r >> 2), lim = tq - key0 - 4 * hi; if (c > lim) s0[r] = -INFINITY; if (c + 32 > lim) s1[r] = -INFINITY; }
            }
            float mx = fmaxf(s0[0], s1[0]);
#pragma unroll
            for (int r = 1; r < 16; ++r) mx = fmaxf(mx, fmaxf(s0[r], s1[r]));
            mx = fmaxf(mx, __shfl_xor(mx, 32));
            const float mxs = mx * LOG2E;
            if (__any(mxs > ms + 8.0f)) {
                const float msn = fmaxf(ms, mxs); const float f = __builtin_amdgcn_exp2f(ms - msn); lsum *= f; ms = msn;
#pragma unroll
                for (int dt = 0; dt < 4; ++dt)
#pragma unroll
                    for (int r = 0; r < 16; ++r) O[dt][r] *= f;
            }
            float ps = 0.f;
#pragma unroll
            for (int r = 0; r < 16; ++r) { s0[r] = __builtin_amdgcn_exp2f(s0[r] * LOG2E - ms); ps += s0[r]; }
            if (!meta) {
#pragma unroll
                for (int r = 0; r < 16; ++r) { s1[r] = __builtin_amdgcn_exp2f(s1[r] * LOG2E - ms); ps += s1[r]; }
            }
            lsum += ps;
            __builtin_amdgcn_s_setprio(1);
            { const bf16x8 pf = pack_step(s0, 0);
              O[0] = MFMA32(vpre0, pf, O[0]); O[1] = MFMA32(vpre1, pf, O[1]); O[2] = MFMA32(vpre2, pf, O[2]); O[3] = MFMA32(vpre3, pf, O[3]); }
            if (!meta) {
                { const bf16x8 pf = pack_step(s0, 1);
                  O[0] = MFMA32(vprf0, pf, O[0]); O[1] = MFMA32(vprf1, pf, O[1]);
#pragma unroll
                  for (int dt = 2; dt < 4; ++dt) { const bf16x8 vf = VFRAG(vb, 16 * DV_STR + 64 * dt, DV_STR); O[dt] = MFMA32(vf, pf, O[dt]); } }
#pragma unroll
                for (int s2 = 0; s2 < 2; ++s2) { const bf16x8 pf = pack_step(s1, s2);
#pragma unroll
                    for (int dt = 0; dt < 4; ++dt) { const bf16x8 vf = VFRAG(vb, (32 + 16 * s2) * DV_STR + 64 * dt, DV_STR); O[dt] = MFMA32(vf, pf, O[dt]); } }
            }
            __builtin_amdgcn_s_setprio(0);
        }
        if (it + 1 < nt) D_STORE((it + 1) & 1);
        __syncthreads();
    }
#undef D_LOAD
#undef D_STORE
    const float lt = lsum + __shfl_xor(lsum, 32);
    LAS float* xch = (LAS float*)lds + (size_t)(wq * 64) * 64 + lane;
    if (map == 1) { const float sc = lam / lt;
#pragma unroll
        for (int dt = 0; dt < 4; ++dt)
#pragma unroll
            for (int r = 0; r < 16; ++r) xch[(dt * 16 + r) * 64] = O[dt][r] * sc; }
    __syncthreads();
    if (map == 0 && !dry) { const float il = 1.0f / lt; float q = 0.f;
#pragma unroll
        for (int dt = 0; dt < 4; ++dt)
#pragma unroll
            for (int r = 0; r < 16; ++r) { const float o = O[dt][r] * il - xch[(dt * 16 + r) * 64]; O[dt][r] = o; q += o * o; }
        q += __shfl_xor(q, 32);
        const float rs = 0.8f / sqrtf(q * (1.0f / 128.0f) + EPS);
        LAS unsigned char* stg = lds + (size_t)wq * (64 * 64 * 4);
        const float* sg = F.in[8];
#pragma unroll
        for (int dt = 0; dt < 4; ++dt)
#pragma unroll
            for (int c = 0; c < 4; ++c) { const int d = 32 * dt + 8 * c + 4 * hi; const f32x4 g = *(const f32x4*)(sg + d);
                *(LAS u32x2*)(stg + r32 * 272 + 2 * d) = (u32x2){cvtpk(O[dt][4 * c] * rs * g.x, O[dt][4 * c + 1] * rs * g.y), cvtpk(O[dt][4 * c + 2] * rs * g.z, O[dt][4 * c + 3] * rs * g.w)}; }
        bf16* ob = QA + (rowbase + tqw) * 1024 + 128 * h;
#pragma unroll
        for (int j = 0; j < 8; ++j) { const int id = lane + 64 * j, row = id >> 4, ch = id & 15; const u32x4 v = *(const LAS u32x4*)(stg + row * 272 + ch * 16); *(u32x4*)(ob + (size_t)row * 1024 + ch * 8) = v; }
    }
}

constexpr int SK_STR = 144, SV_STR = 192, SK_BUF = 128 * SK_STR, SV_BUF = 128 * SV_STR, S_KOFF = 0, S_VOFF = 2 * SK_BUF;
__device__ __forceinline__ void sb_unit(const Frame& F, int b, int hd, int qi, int dry) {
    LAS unsigned char* lds = F.lds;
    const int tid = F.tid, lane = F.lane, wid = F.wave, r32 = lane & 31, hi = lane >> 5;
    const size_t rowbase = (size_t)b * LT;
    const int tq0 = NMETA + 256 * qi, tqw = tq0 + 32 * wid, tq = tqw + r32;
    bf16* QB = (bf16*)(F.ws + WS_SEC) + 3 * SEC_ELEMS; const bf16* KB = QB + SEC_ELEMS; const bf16* VB = QB + 2 * SEC_ELEMS;
    bf16x8 qf[4];
    { const bf16* qp = QB + (rowbase + tq) * 1024 + 64 * hd + 8 * hi;
#pragma unroll
      for (int ks = 0; ks < 4; ++ks) qf[ks] = *(const bf16x8*)(qp + 16 * ks); }
    const int srow = tid >> 3, sc16 = tid & 7;
    const bf16* kg = KB + (rowbase + srow) * 1024 + 64 * hd + sc16 * 8;
    const bf16* vg = VB + (rowbase + srow) * 1024 + 64 * hd + sc16 * 8;
    const int klds = S_KOFF + srow * SK_STR + sc16 * 16, vlds = S_VOFF + srow * SV_STR + sc16 * 16;
    u32x4 st0, st1, st2, st3;
#define S_LOAD(key0) do { st0 = *(const u32x4*)(kg + (size_t)(key0) * 1024); st1 = *(const u32x4*)(kg + (size_t)((key0) + 64) * 1024); st2 = *(const u32x4*)(vg + (size_t)(key0) * 1024); st3 = *(const u32x4*)(vg + (size_t)((key0) + 64) * 1024); } while (0)
#define S_STORE(buf) do { *(LAS u32x4*)(lds + klds + (buf) * SK_BUF) = st0; *(LAS u32x4*)(lds + klds + (buf) * SK_BUF + 64 * SK_STR) = st1; \
        *(LAS u32x4*)(lds + vlds + (buf) * SV_BUF) = st2; *(LAS u32x4*)(lds + vlds + (buf) * SV_BUF + 64 * SV_STR) = st3; } while (0)
    const int jmax = 2 * qi + 1, nt = jmax + 2;
    __syncthreads();
    S_LOAD(NMETA + 128 * jmax); S_STORE(0);
    __syncthreads();
    f32x16 O[2];
#pragma unroll
    for (int dt = 0; dt < 2; ++dt)
#pragma unroll
        for (int r = 0; r < 16; ++r) O[dt][r] = 0.f;
    float C = 0.f;
    bool dead = false;
    constexpr float SB_DEAD = -150.0f;
    LAS int* flags = (LAS int*)(lds + S_VOFF + 2 * SV_BUF);
    const int kra = S_KOFF + r32 * SK_STR + hi * 16;
    const int vra = S_VOFF + (4 * hi + ((lane & 15) >> 2)) * SV_STR + (16 * ((lane >> 4) & 1) + 4 * (lane & 3)) * 2;
    for (int it = 0; it < nt; ++it) {
        const bool meta = (it > jmax);
        const int key0 = meta ? 0 : NMETA + 128 * (jmax - it);
        if (it + 1 < nt) { const int nk = (it + 1 > jmax) ? 0 : NMETA + 128 * (jmax - it - 1); S_LOAD(nk); }
        if (!dead && (meta || key0 < tqw + 31)) {
            const LAS unsigned char* kb = lds + kra + (it & 1) * SK_BUF;
            const LAS unsigned char* vb = lds + vra + (it & 1) * SV_BUF;
#define SB_HALF(KO)  do { f32x16 S_, om_; \
                _Pragma("unroll") for (int r = 0; r < 16; ++r) S_[r] = 0.f; \
                _Pragma("unroll") for (int ks = 0; ks < 4; ++ks) { const bf16x8 kf_ = *(const LAS bf16x8*)(kb + (KO) * SK_STR + ks * 32); S_ = MFMA32(kf_, qf[ks], S_); } \
                const int lim_ = (meta ? NMETA : tq) - key0 - (KO) - 4 * hi;     \
                  \
                const bf16x8 vq0_ = VFRAG(vb, (KO) * SV_STR, SV_STR), vq1_ = VFRAG(vb, (KO) * SV_STR + 64, SV_STR), vq2_ = VFRAG(vb, ((KO) + 16) * SV_STR, SV_STR), vq3_ = VFRAG(vb, ((KO) + 16) * SV_STR + 64, SV_STR); \
                  \
                  \
                  \
                const float sc_ = __builtin_amdgcn_exp2f(run); \
                _Pragma("unroll") for (int r = 0; r < 16; ++r) { const float z = fmaxf(S_[r], -126.0f); const bool valid = (r & 3) + 8 * (r >> 2) < lim_; const float e = __builtin_amdgcn_exp2f(-z); \
                    const float bt = __builtin_amdgcn_rcpf(1.0f + e); om_[r] = valid ? e * bt : 1.0f; S_[r] = valid ? bt * sc_ : 0.f; } \
                float rp_ = 1.0f; \
                _Pragma("unroll") for (int c = 3; c >= 0; --c) { const float cs = (om_[4 * c] * om_[4 * c + 1]) * (om_[4 * c + 2] * om_[4 * c + 3]); const float co = __shfl_xor(cs, 32); \
                    const float e3 = rp_ * (hi == 0 ? co : 1.0f), e2 = e3 * om_[4 * c + 3], e1 = e2 * om_[4 * c + 2], e0 = e1 * om_[4 * c + 1]; \
                    S_[4 * c + 3] *= e3; S_[4 * c + 2] *= e2; S_[4 * c + 1] *= e1; S_[4 * c] *= e0; \
                    rp_ *= cs * co; } \
                run += __builtin_amdgcn_logf(rp_);     \
                { const bf16x8 pf0_ = pack_step(S_, 0), pf1_ = pack_step(S_, 1); \
                  O[0] = MFMA32(vq0_, pf0_, O[0]); O[1] = MFMA32(vq1_, pf0_, O[1]); O[0] = MFMA32(vq2_, pf1_, O[0]); O[1] = MFMA32(vq3_, pf1_, O[1]); } \
            } while (0)
            float run = C;
            if (!meta && key0 + 96 < tqw + 31) SB_HALF(96);
            if (!meta && key0 + 64 < tqw + 31 && __any(run >= SB_DEAD)) SB_HALF(64);
            if (!meta && key0 + 32 < tqw + 31 && __any(run >= SB_DEAD)) SB_HALF(32);
            if (__any(run >= SB_DEAD)) SB_HALF(0);
            C = run; dead = !__any(C >= SB_DEAD);
#undef SB_HALF
        }
        if (it + 1 < nt) S_STORE((it + 1) & 1);
        if (lane == 0) flags[(it & 1) * 8 + wid] = dead ? 1 : 0;
        __syncthreads();
        if (!__any(flags[(it & 1) * 8 + (lane & 7)] == 0)) break;
    }
#undef S_LOAD
#undef S_STORE
    if (dry) return;
    LAS unsigned char* stg = lds + (size_t)wid * (32 * 144);
#pragma unroll
    for (int dt = 0; dt < 2; ++dt)
#pragma unroll
        for (int c = 0; c < 4; ++c) { const int d = 32 * dt + 8 * c + 4 * hi;
            *(LAS u32x2*)(stg + r32 * 144 + 2 * d) = (u32x2){cvtpk(O[dt][4 * c], O[dt][4 * c + 1]), cvtpk(O[dt][4 * c + 2], O[dt][4 * c + 3])}; }
    bf16* ob = QB + (rowbase + tqw) * 1024 + 64 * hd;
#pragma unroll
    for (int j = 0; j < 4; ++j) { const int id = lane + 64 * j, row = id >> 3, ch = id & 7; const u32x4 v = *(const LAS u32x4*)(stg + row * 144 + ch * 16); *(u32x4*)(ob + (size_t)row * 1024 + ch * 8) = v; }
}
__device__ __forceinline__ void attn_phase(const Frame& F) {
    const float a1 = wave_sum(F.in[4][F.lane] * F.in[5][F.lane]), a2 = wave_sum(F.in[6][F.lane] * F.in[7][F.lane]);
    const float lam = expf(a1) - expf(a2) + 0.2f;
    for (int rep = PROBE_DIFF ? 0 : 1; rep < 2; ++rep)
    for (int pidx = F.vcu; pidx < 1024; pidx += F.G) {
        const int bh = pidx >> 4, p = pidx & 15;
        diff_unit(F, bh >> 3, bh & 7, p, lam, rep == 0);
        diff_unit(F, bh >> 3, bh & 7, 31 - p, lam, rep == 0);
    }
    for (int rep = PROBE_SB ? 0 : 1; rep < 2; ++rep)
    for (int pidx = F.vcu; pidx < 1024; pidx += F.G) {
        const int bh = pidx >> 3, p = pidx & 7;
        sb_unit(F, bh >> 4, bh & 15, p, rep == 0);
        sb_unit(F, bh >> 4, bh & 15, 15 - p, rep == 0);
    }
    __syncthreads();
}
__device__ __forceinline__ void final_norm(const Frame& F) {
    const int gw = F.vcu * NWAVES + F.wave, NGW = F.G * NWAVES;
    const f32x4* g4 = (const f32x4*)F.in[15] + F.lane;
    const bf16* H3 = (const bf16*)(F.ws + WS_SEC) + 5 * SEC_ELEMS;
    constexpr int NR = 4;
    for (int R0 = gw; R0 < MQ; R0 += NR * NGW) {
        u32x2 w[NR][4]; bool has[NR]; int Rr[NR];
#pragma unroll
        for (int rr = 0; rr < NR; ++rr) { const int R = R0 + rr * NGW; has[rr] = R < MQ; Rr[rr] = has[rr] ? R : R0; const u32x2* hr = (const u32x2*)(H3 + (size_t)Rr[rr] * DM) + F.lane;
#pragma unroll
            for (int j = 0; j < 4; ++j) w[rr][j] = hr[64 * j]; }
#pragma unroll
        for (int rr = 0; rr < NR; ++rr) { f32x4 v[4]; float s = 0.f;
#pragma unroll
            for (int j = 0; j < 4; ++j) { v[j] = (f32x4){pg8::bf_lo(w[rr][j].x), pg8::bf_hi(w[rr][j].x), pg8::bf_lo(w[rr][j].y), pg8::bf_hi(w[rr][j].y)}; s += (v[j].x * v[j].x + v[j].y * v[j].y) + (v[j].z * v[j].z + v[j].w * v[j].w); }
            const float rstd = 1.0f / sqrtf(wave_sum(s) * (1.0f / DM) + EPS);
            f32x4* xr = (f32x4*)(F.out + (size_t)Rr[rr] * DM) + F.lane;
            if (has[rr]) {
#pragma unroll
                for (int j = 0; j < 4; ++j) xr[64 * j] = v[j] * rstd * g4[64 * j]; } }
    }
}

__device__ __forceinline__ void meta_proj(const Frame& F, int v) {
    const int lane = F.lane, w = F.wave, cbk = w & 1, kq = w >> 1, n0 = 32 * v;
    const bf16* ap = (const bf16*)(F.ws + WS_HNM) + (size_t)(lane & 15) * DM + 256 * kq + 8 * (lane >> 4);
    const bf16* bp = (const bf16*)(F.ws + WS_WIN) + (size_t)(n0 + 16 * cbk + (lane & 15)) * DM + 256 * kq + 8 * (lane >> 4);
    bf16x8 af[8], bfr[8];
#pragma unroll
    for (int ks = 0; ks < 8; ++ks) { af[ks] = *(const bf16x8*)(ap + 32 * ks); bfr[ks] = *(const bf16x8*)(bp + 32 * ks); }
    f32x4 acc = {0.f, 0.f, 0.f, 0.f};
#pragma unroll
    for (int ks = 0; ks < 8; ++ks) acc = __builtin_amdgcn_mfma_f32_16x16x32_bf16(af[ks], bfr[ks], acc, 0, 0, 0);
    LAS f32x4* red = (LAS f32x4*)F.lds;
    red[(kq * 2 + cbk) * 64 + lane] = acc;
    __syncthreads();
    if (kq == 0) {
        const f32x4 s = (red[(0 * 2 + cbk) * 64 + lane] + red[(1 * 2 + cbk) * 64 + lane]) + (red[(2 * 2 + cbk) * 64 + lane] + red[(3 * 2 + cbk) * 64 + lane]);
        const int c = n0 + 16 * cbk + (lane & 15), sec = c >> 10, cs = c & 1023;
        bf16* base = (bf16*)(F.ws + WS_SEC) + (size_t)sec * SEC_ELEMS + cs;
        const float* rope = (const float*)(F.ws + WS_ROPE);
#pragma unroll
        for (int i = 0; i < 4; ++i) { const int t = 4 * (lane >> 4) + i; float val = s[i];
            if (sec < 2) {
                const float o = __shfl_xor(val, 1); const int ip = (cs & 63) >> 1; const float cc = rope[(t * 32 + ip) * 2], sn = rope[(t * 32 + ip) * 2 + 1];
                val = (lane & 1) ? val * cc + o * sn : val * cc - o * sn;
                if (sec == 0) val *= 0.125f;
            } else if (sec == 3) val *= 0.125f * LOG2E;
            const unsigned short hb = (unsigned short)(cvtpk(val, 0.f) & 0xffffu);
#pragma unroll
            for (int b = 0; b < BATCH; ++b) base[((size_t)b * LT + t) * 1024] = hb; }
    }
    __syncthreads();
}

#define XB_TMO      128
#define XB_XCNT(j)  (256  + 64 * (j))
#define XB_XSUB(j)  (1280 + 64 * (j))
#define XB_XGEN(j)  (2304 + 64 * (j))
#define XB_TOP      3328
#define XB_TOPGEN   3392
#define XCD_BAR_WORDS 3456
#define XB_SPIN_CAP (1u << 18)

__device__ __forceinline__ unsigned xb_ld(unsigned* p)              { return __hip_atomic_load(p, __ATOMIC_RELAXED, __HIP_MEMORY_SCOPE_AGENT); }
__device__ __forceinline__ unsigned xb_add(unsigned* p, unsigned v) { return __hip_atomic_fetch_add(p, v, __ATOMIC_RELAXED, __HIP_MEMORY_SCOPE_AGENT); }
__device__ __forceinline__ unsigned xb_xcc_id() { return (unsigned)__builtin_amdgcn_s_getreg((3 << 11) | 20) & 0xFu; }
#define XB_SPIN(cond, bar) do { unsigned _sp = 0; while (cond) { __builtin_amdgcn_s_sleep(1); \
    if ((++_sp & 255u) == 0u) { if (xb_ld(&(bar)[XB_TMO])) break; if (_sp > XB_SPIN_CAP) { atomicAdd(&(bar)[XB_TMO], 1u); break; } } } } while (0)

struct XcdBarrier {
    unsigned* bar; unsigned x;
    volatile LAS unsigned* st;
};

__device__ __forceinline__ XcdBarrier xcd_barrier_post(unsigned* bar, volatile LAS unsigned* st) {
    XcdBarrier b; b.bar = bar; b.x = xb_xcc_id(); b.st = st;
    if (threadIdx.x == 0) (void)xb_add(&bar[XB_XCNT(b.x)], 1u);
    return b;
}
__device__ __forceinline__ void xcd_barrier_complete(unsigned* bar, unsigned x, unsigned& nloc, unsigned& nx) {
    const unsigned G = gridDim.x * gridDim.y * gridDim.z;
    unsigned sum, cnt, mine, sp = 0u;
    for (;;) {
        sum = 0u; cnt = 0u; mine = 0u;
#pragma unroll
        for (unsigned j = 0; j < 16; ++j) { const unsigned c = xb_ld(&bar[XB_XCNT(j)]); sum += c; cnt += (c > 0u) ? 1u : 0u; mine = (j == x) ? c : mine; }
        if (sum == G) break;
        __builtin_amdgcn_s_sleep(1);
        if ((++sp & 255u) == 0u) { if (xb_ld(&bar[XB_TMO])) break; if (sp > XB_SPIN_CAP) { atomicAdd(&bar[XB_TMO], 1u); break; } }
    }
    nloc = mine > 0u ? mine : 1u; nx = cnt > 0u ? cnt : 1u;
}

__device__ __forceinline__ void xcd_barrier(const XcdBarrier& b) {
    asm volatile("s_waitcnt vmcnt(0)" ::: "memory");
    __syncthreads();
    if (threadIdx.x == 0) {
        unsigned* bar = b.bar;
        __builtin_amdgcn_s_waitcnt(0);
        unsigned nloc = b.st[0], nx = b.st[1];
        if (nloc == 0u) { xcd_barrier_complete(bar, b.x, nloc, nx); b.st[0] = nloc; b.st[1] = nx; }
        const unsigned old = xb_add(&bar[XB_XSUB(b.x)], 1u);
        const unsigned gen = old / nloc;
        if (old + 1u == (gen + 1u) * nloc) {
            __builtin_amdgcn_fence(__ATOMIC_RELEASE, "agent");
            asm volatile("s_waitcnt vmcnt(0)" ::: "memory");
            const unsigned og = xb_add(&bar[XB_TOP], 1u);
            const unsigned tg = og / nx;
            if (og + 1u == (tg + 1u) * nx) xb_add(&bar[XB_TOPGEN], 1u);
            else XB_SPIN(xb_ld(&bar[XB_TOPGEN]) == tg, bar);
            __builtin_amdgcn_fence(__ATOMIC_ACQUIRE, "agent");
            xb_add(&bar[XB_XGEN(b.x)], 1u);
            asm volatile("s_waitcnt vmcnt(0)" ::: "memory");
        } else {
            XB_SPIN(xb_ld(&bar[XB_XGEN(b.x)]) == gen, bar);
            __builtin_amdgcn_fence(__ATOMIC_ACQUIRE, "agent");
            asm volatile("s_waitcnt vmcnt(0)" ::: "memory");
        }
    }
    __syncthreads();
}

struct Args { const float* in[16]; float* out; unsigned char* ws; int ph_lo, ph_hi; };
__global__ void __launch_bounds__(NWAVES * 64, 2) mk_fwd(Args args) {
    extern __shared__ __attribute__((aligned(16))) unsigned char lds_raw[];
    cg::grid_group grid = cg::this_grid();
    Frame F;
    F.lds = (LAS unsigned char*)lds_raw;
    F.tid = threadIdx.x; F.lane = F.tid & 63; F.wave = __builtin_amdgcn_readfirstlane(F.tid >> 6);
    F.G = gridDim.x; { const int bx = blockIdx.x; F.vcu = (F.G % 8 == 0) ? (bx % 8) * (F.G / 8) + bx / 8 : bx; }
#pragma unroll
    for (int i = 0; i < 16; ++i) F.in[i] = args.in[i];
    F.out = args.out; F.ws = args.ws;
    unsigned char* ws = args.ws;
    const int lo = args.ph_lo, hi = args.ph_hi;
    volatile LAS unsigned* barst = (volatile LAS unsigned*)(F.lds + LDS_BARW);
    if (F.tid < 4) barst[F.tid] = 0u;
    __syncthreads();
    XcdBarrier xbar = xcd_barrier_post((unsigned*)(ws + WS_BAR), barst);
#define IN(k) (lo <= (k) && (k) < hi)
    if (lo > 1000) grid.sync();
#define SEAM(k) do { if (IN(k) && IN((k) + 1)) xcd_barrier(xbar); } while (0)
    bf16* SEC = (bf16*)(ws + WS_SEC);
    bf16* GATES = (bf16*)args.out;
    float* SS = (float*)(ws + WS_SS);
    if (IN(0)) p0_prologue(F);
    SEAM(0);
    if (IN(1)) {
        if (F.vcu < 192) meta_proj(F, F.vcu);
        pg8::Gemm g{(const bf16*)(ws + WS_HN), (const bf16*)(ws + WS_WIN), MQ, DIN, DM, 0}; pg8::StaticOrder S; S.init(MQ, DIN, F.G, (int)blockIdx.x);
        pg8::EpiProj E{SEC, SEC_ELEMS, GATES, (const float*)(ws + WS_ROPE), F.lds + pg8::EPI_STG_OFF};
        for (int rep = PROBE_P1 ? 0 : 1; rep < 2; ++rep)
        pg8::gemm_phase<pg8::EpiProj, pg8::StaticOrder, true, true>(F.lds, g, S, E);
    }
    SEAM(1);
    if (IN(2)) attn_phase(F);
    SEAM(2);
    if (IN(3)) {
        bf16* TMP = SEC + SEC_ELEMS; bf16* MERGED = SEC + 2 * SEC_ELEMS;
        { pg8::Gemm g{SEC, (const bf16*)(ws + WS_WA), MQ, DM, DM, 1}; pg8::StaticOrder S; S.init(MQ, DM, F.G, (int)blockIdx.x);
          pg8::EpiGate<0> E{GATES, TMP, MERGED, F.lds + pg8::EPI_STG_OFF};
          pg8::gemm_phase<pg8::EpiGate<0>, pg8::StaticOrder, true, true>(F.lds, g, S, E); }
        { pg8::Gemm g{SEC + 3 * SEC_ELEMS, (const bf16*)(ws + WS_WB), MQ, DM, DM, 1}; pg8::StaticOrder S; S.init(MQ, DM, F.G, (int)blockIdx.x);
          pg8::EpiGate<1> E{GATES + (size_t)MQ * 1024, TMP, MERGED, F.lds + pg8::EPI_STG_OFF};
          pg8::gemm_phase<pg8::EpiGate<1>, pg8::StaticOrder, true, true>(F.lds, g, S, E); }
    }
    SEAM(3);
    if (IN(4)) {
        pg8::Gemm g{SEC + 2 * SEC_ELEMS, (const bf16*)(ws + WS_WO), MQ, DM, DM, 0}; pg8::StaticOrder S; S.init(MQ, DM, F.G, (int)blockIdx.x);
        pg8::EpiOut E{F.in[0], args.out, SEC + 4 * SEC_ELEMS, SS, F.lds + pg8::EPI_STG_OFF};
        pg8::gemm_phase<pg8::EpiOut, pg8::StaticOrder, true, true>(F.lds, g, S, E);
    }
    SEAM(4);
    if (IN(5)) {
        { float* R2 = (float*)(ws + WS_R2);
          for (int R = F.vcu * (NWAVES * 64) + F.tid; R < MQ; R += F.G * NWAVES * 64) { const f32x4* sp = (const f32x4*)(SS + (size_t)R * 16); const f32x4 s0 = sp[0], s1 = sp[1], s2 = sp[2], s3 = sp[3];
              const float sq = ((s0[0] + s0[1]) + (s0[2] + s0[3])) + ((s1[0] + s1[1]) + (s1[2] + s1[3])) + ((s2[0] + s2[1]) + (s2[2] + s2[3])) + ((s3[0] + s3[1]) + (s3[2] + s3[3]));
              R2[R] = 1.0f / (sq * (1.0f / 1024.0f) + 1e-6f); } }
        pg8::Gemm g{SEC + 4 * SEC_ELEMS, (const bf16*)(ws + WS_WUP), MQ, FF, DM, 0}; pg8::StaticOrder S; S.init(MQ, FF, F.G, (int)blockIdx.x);
        pg8::EpiUp E{SS, SEC, F.lds + pg8::EPI_STG_OFF};
        pg8::gemm_phase<pg8::EpiUp, pg8::StaticOrder, true, true>(F.lds, g, S, E);
    }
    SEAM(5);
    if (IN(6)) {
        pg8::Gemm g{SEC, (const bf16*)(ws + WS_WDN), MQ, DM, FF, 0}; pg8::StaticOrder S; S.init(MQ, DM, F.G, (int)blockIdx.x);
        pg8::EpiDown E{SEC + 4 * SEC_ELEMS, SEC + 5 * SEC_ELEMS, F.lds + pg8::EPI_STG_OFF, (const float*)(ws + WS_R2)};
        pg8::gemm_phase<pg8::EpiDown, pg8::StaticOrder, true, true>(F.lds, g, S, E);
    }
    SEAM(6);
    if (IN(7)) final_norm(F);
#undef IN
#undef SEAM
}

extern "C" void kernel_launch(void* const* d_in, const int* in_sizes, int n_in, void* d_out, int out_size, void* d_ws, size_t ws_size, hipStream_t stream) {
    static int grid = 0;
    if (grid == 0) {
        if (n_in != 16 || in_sizes[0] != MQ * DM || out_size != MQ * DM || ws_size < WS_END) { fprintf(stderr, "kernel_launch: unexpected shapes (n_in %d in0 %d out %d ws %zu); nothing launched\n", n_in, n_in > 0 ? in_sizes[0] : -1, out_size, ws_size); grid = -1; return; }
        int dev = 0, cus = 0, per_cu = 0;
        (void)hipGetDevice(&dev); (void)hipDeviceGetAttribute(&cus, hipDeviceAttributeMultiprocessorCount, dev);
        if (hipFuncSetAttribute((const void*)mk_fwd, hipFuncAttributeMaxDynamicSharedMemorySize, LDS_BYTES) != hipSuccess) { fprintf(stderr, "kernel_launch: hipFuncSetAttribute failed\n"); grid = -1; return; }
        if (hipOccupancyMaxActiveBlocksPerMultiprocessor(&per_cu, (const void*)mk_fwd, NWAVES * 64, LDS_BYTES) != hipSuccess || per_cu < 1) { fprintf(stderr, "kernel_launch: occupancy query says %d\n", per_cu); per_cu = 1; }
        (void)hipGetLastError();
        grid = cus;
        if (grid <= 0) grid = 256;
    }
    if (grid < 0) return;
    if (hipMemsetAsync((char*)d_ws + WS_BAR, 0, XCD_BAR_WORDS * sizeof(unsigned), stream) != hipSuccess) { fprintf(stderr, "kernel_launch: hipMemsetAsync of the barrier words failed\n"); return; }
    Args a{};
    for (int i = 0; i < 16; ++i) a.in[i] = (const float*)d_in[i];
    a.out = (float*)d_out; a.ws = (unsigned char*)d_ws;
#if MK_MULTI
    for (int p = 0; p < 8; ++p) { a.ph_lo = p; a.ph_hi = p + 1; hipLaunchKernelGGL(mk_fwd, dim3(grid), dim3(NWAVES * 64), LDS_BYTES, stream, a); }
#else
    a.ph_lo = 0; a.ph_hi = 8;
    void* kargs[] = {&a};
    hipError_t e = hipLaunchCooperativeKernel((const void*)mk_fwd, dim3(grid), dim3(NWAVES * 64), kargs, LDS_BYTES, stream);
    if (e != hipSuccess) fprintf(stderr, "kernel_launch: cooperative launch failed: %s (grid %d)\n", hipGetErrorString(e), grid);
#endif
}
```

```cpp
#include <hip/hip_runtime.h>
#include <hip/hip_cooperative_groups.h>
#include <cstdio>
#include <cstdint>
namespace cg = cooperative_groups;
#ifndef PROBE_DIFF
#define PROBE_DIFF 0
#endif
#ifndef PROBE_SB
#define PROBE_SB 0
#endif
#ifndef PROBE_P1
#define PROBE_P1 0
#endif
#ifndef MK_MULTI
#define MK_MULTI 0
#endif
namespace pg8 {
#define PG8_LAS __attribute__((address_space(3)))
typedef unsigned short bf16_t;
typedef short bf16x8 __attribute__((ext_vector_type(8)));
typedef float f32x4 __attribute__((ext_vector_type(4)));
typedef unsigned u32x4 __attribute__((ext_vector_type(4)));
constexpr int BM = 256, BK = 64, HALF = 128, HTB = HALF * BK * 2  , STAGE_BYTES = 8 * HTB, NXCD = 8, WGM = 8;

__host__ __device__ __forceinline__ int lds_byte(int r, int c) { const int st = (r >> 4) * 2 + (c >> 5), rr = r & 15, cc = c & 31, ob = rr * 64 + cc * 2; return st * 1024 + (ob ^ (((ob >> 9) & 1) << 5)); }
__host__ __device__ __forceinline__ void stage_rc(int b, int& R, int& C) { const int st = b / 1024, sb = b % 1024, swz = sb ^ (((sb >> 9) & 1) << 5); R = (st >> 1) * 16 + swz / 64; C = (st & 1) * 32 + (swz % 64) / 2; }
__host__ __device__ __forceinline__ int perm32(int rho) { const int n = rho >> 4, i = rho & 15; return 8 * (i >> 2) + 4 * n + (i & 3); }

struct Unit { int pm, pn; };
struct Gemm { const bf16_t* A; const bf16_t* Bt; int M, N, K; int skip;
    __device__ __forceinline__ const char* a_ptr(int pm) const { return (const char*)A + ((size_t)pm * 256 + (skip ? 16 * ((pm >> 4) + 1) : 0)) * (size_t)K * 2; } };

struct StaticOrder {
    int nM, nN, nwg, G, c;
    __host__ __device__ void init(int M, int N, int G_, int c_) { nM = M / BM; nN = N / BM; nwg = nM * nN; G = G_; c = c_; }
    __host__ __device__ bool next(int i, Unit& u) const {
        const long L = (long)i * G + c; if (L >= nwg) return false;
        int wgid = (int)L; { const int q = nwg / NXCD, r = nwg % NXCD, xcd = wgid % NXCD, off = wgid / NXCD; wgid = (xcd < r ? xcd * (q + 1) : r * (q + 1) + (xcd - r) * q) + off; }
        const int nig = WGM * nN, gid = wgid / nig, fm = gid * WGM, gsz = (nM - fm) < WGM ? (nM - fm) : WGM;
        u.pm = fm + ((wgid % nig) % gsz); u.pn = (wgid % nig) / gsz; return true;
    }
    __device__ __forceinline__ void a_ready(const Unit&) const {}
    __device__ __forceinline__ void done(const Unit&) const {}
};

typedef float f32x2 __attribute__((ext_vector_type(2))); typedef __bf16 bf16x2_t_ __attribute__((ext_vector_type(2)));
__device__ __forceinline__ unsigned cvt_pk_bf16(float lo, float hi) { f32x2 v = {lo, hi}; bf16x2_t_ b = __builtin_convertvector(v, bf16x2_t_); return __builtin_bit_cast(unsigned, b); }

typedef unsigned u32x4 __attribute__((ext_vector_type(4)));
__device__ __forceinline__ float bf_lo(unsigned w) { return __uint_as_float(w << 16); }
__device__ __forceinline__ float bf_hi(unsigned w) { return __uint_as_float(w & 0xffff0000u); }
__device__ __forceinline__ u32x4 pack8(const f32x4& a, const f32x4& b) { u32x4 w; w.x = cvt_pk_bf16(a[0], a[1]); w.y = cvt_pk_bf16(a[2], a[3]); w.z = cvt_pk_bf16(b[0], b[1]); w.w = cvt_pk_bf16(b[2], b[3]); return w; }
__device__ __forceinline__ float sigmoidf_(float x) { return __builtin_amdgcn_rcpf(1.0f + __builtin_amdgcn_exp2f(x * -1.4426950408889634f)); }
constexpr int E_L = 4112, E_MFLAT = 8 * 4112, E_MQ = 8 * 4096;

constexpr int EPI_STG_OFF = 131072 + 1024, EPI_STG_WAVE = 16 * 144;
__device__ __forceinline__ void store_rows16(PG8_LAS unsigned char* stg, bf16_t* gbase, size_t ld, int fr, int fq, const u32x4& w0, const u32x4& w1) {
    *(PG8_LAS u32x4*)(stg + fr * 144 + fq * 16) = w0; *(PG8_LAS u32x4*)(stg + fr * 144 + 64 + fq * 16) = w1;
    const int lane = fr + 16 * fq;
#pragma unroll
    for (int j = 0; j < 2; ++j) { const int c = lane + 64 * j, row = c >> 3, ch = c & 7; const u32x4 v = *(const PG8_LAS u32x4*)(stg + row * 144 + ch * 16); *(u32x4*)(gbase + (size_t)row * ld + ch * 8) = v; }
}
struct EpiProj {
    static constexpr bool PERM = true, AFTER_DRAIN = false;
    bf16_t* P; size_t sec_stride; bf16_t* G; const float* rope; PG8_LAS unsigned char* stg;
    __device__ __forceinline__ void operator()(const f32x4 (&acc)[2][2][4][2], const Unit& u, int wr, int wc, int fr, int fq) const {
        const int sec = u.pn >> 2, colt = (u.pn & 3) * 256;
        const int row0 = u.pm * BM + wr * 64 + fr, col0 = colt + wc * 64 + 8 * fq, colw = colt + wc * 64; PG8_LAS unsigned char* st = stg + (wr * 4 + wc) * EPI_STG_WAVE;
        if (sec < 2) {
            const float sc = sec == 0 ? 0.125f : 1.0f;
#pragma unroll
            for (int ai = 0; ai < 2; ++ai) {
                f32x4 c0[4][2], c1[4][2];
#pragma unroll
                for (int m = 0; m < 4; ++m) { const int Rq = row0 + ai * HALF + m * 16; const int t = (Rq & 4095) + 16;
#pragma unroll
                    for (int bj = 0; bj < 2; ++bj) { const f32x4* rp = (const f32x4*)(rope + ((size_t)t * 32 + 16 * bj + 4 * fq) * 2); c0[m][bj] = rp[0]; c1[m][bj] = rp[1]; } }
#pragma unroll
                for (int m = 0; m < 4; ++m) { const int Rq = row0 + ai * HALF + m * 16; const int R = Rq + 16 * ((Rq >> 12) + 1);
                    u32x4 wv[2];
#pragma unroll
                    for (int bj = 0; bj < 2; ++bj) { const f32x4 v0 = acc[ai][bj][m][0], v1 = acc[ai][bj][m][1]; f32x4 o0, o1;
                        o0[0] = (v0[0] * c0[m][bj][0] - v0[1] * c0[m][bj][1]) * sc; o0[1] = (v0[1] * c0[m][bj][0] + v0[0] * c0[m][bj][1]) * sc;
                        o0[2] = (v0[2] * c0[m][bj][2] - v0[3] * c0[m][bj][3]) * sc; o0[3] = (v0[3] * c0[m][bj][2] + v0[2] * c0[m][bj][3]) * sc;
                        o1[0] = (v1[0] * c1[m][bj][0] - v1[1] * c1[m][bj][1]) * sc; o1[1] = (v1[1] * c1[m][bj][0] + v1[0] * c1[m][bj][1]) * sc;
                        o1[2] = (v1[2] * c1[m][bj][2] - v1[3] * c1[m][bj][3]) * sc; o1[3] = (v1[3] * c1[m][bj][2] + v1[2] * c1[m][bj][3]) * sc;
                        wv[bj] = pack8(o0, o1); }
                    store_rows16(st, P + (size_t)sec * sec_stride + (size_t)(R - fr) * 1024 + colw, 1024, fr, fq, wv[0], wv[1]); }
            }
        } else if (sec < 6) {
            const float sc = sec == 3 ? 0.125f * 1.4426950408889634f : 1.0f;
#pragma unroll
            for (int ai = 0; ai < 2; ++ai)
#pragma unroll
                for (int m = 0; m < 4; ++m) { const int Rq = row0 + ai * HALF + m * 16; const int R = Rq + 16 * ((Rq >> 12) + 1);
                    u32x4 wv[2];
#pragma unroll
                    for (int bj = 0; bj < 2; ++bj) { const f32x4 v0 = acc[ai][bj][m][0] * sc, v1 = acc[ai][bj][m][1] * sc; wv[bj] = pack8(v0, v1); }
                    store_rows16(st, P + (size_t)sec * sec_stride + (size_t)(R - fr) * 1024 + colw, 1024, fr, fq, wv[0], wv[1]); }
        } else {
#pragma unroll
            for (int ai = 0; ai < 2; ++ai)
#pragma unroll
                for (int m = 0; m < 4; ++m) { const int Rq = row0 + ai * HALF + m * 16;
                    u32x4 wv[2];
#pragma unroll
                    for (int bj = 0; bj < 2; ++bj) { const f32x4 v0 = acc[ai][bj][m][0], v1 = acc[ai][bj][m][1]; f32x4 o0, o1;
#pragma unroll
                        for (int e = 0; e < 4; ++e) { o0[e] = sigmoidf_(v0[e]); o1[e] = sigmoidf_(v1[e]); }
                        wv[bj] = pack8(o0, o1); }
                    store_rows16(st, G + (size_t)(sec - 6) * ((size_t)E_MQ * 1024) + (size_t)(Rq - fr) * 1024 + colw, 1024, fr, fq, wv[0], wv[1]); }
        }
    }
};
template <int WHICH> struct EpiGate {
    static constexpr bool PERM = true, AFTER_DRAIN = false;
    const bf16_t* G; bf16_t* T; bf16_t* O; PG8_LAS unsigned char* stg;
    __device__ __forceinline__ void operator()(const f32x4 (&acc)[2][2][4][2], const Unit& u, int wr, int wc, int fr, int fq) const {
        const int row0 = u.pm * BM + wr * 64 + fr, col0 = u.pn * BM + wc * 64 + 8 * fq;
#pragma unroll
        for (int ai = 0; ai < 2; ++ai) {
            u32x4 gv[4][2], tv[4][2];
#pragma unroll
            for (int m = 0; m < 4; ++m) { const size_t off = (size_t)(row0 + ai * HALF + m * 16) * 1024 + col0;
#pragma unroll
                for (int bj = 0; bj < 2; ++bj) { gv[m][bj] = *(const u32x4*)(G + off + bj * 32); if (WHICH == 1) tv[m][bj] = *(const u32x4*)(T + off + bj * 32); } }
#pragma unroll
            for (int m = 0; m < 4; ++m) { const size_t off = (size_t)(row0 + ai * HALF + m * 16) * 1024 + col0;
                u32x4 wv[2];
#pragma unroll
                for (int bj = 0; bj < 2; ++bj) { const u32x4 g = gv[m][bj]; const f32x4 v0 = acc[ai][bj][m][0], v1 = acc[ai][bj][m][1]; f32x4 o0, o1;
                    o0[0] = v0[0] * bf_lo(g.x); o0[1] = v0[1] * bf_hi(g.x); o0[2] = v0[2] * bf_lo(g.y); o0[3] = v0[3] * bf_hi(g.y);
                    o1[0] = v1[0] * bf_lo(g.z); o1[1] = v1[1] * bf_hi(g.z); o1[2] = v1[2] * bf_lo(g.w); o1[3] = v1[3] * bf_hi(g.w);
                    if (WHICH == 1) { const u32x4 t = tv[m][bj];
                        o0[0] += bf_lo(t.x); o0[1] += bf_hi(t.x); o0[2] += bf_lo(t.y); o0[3] += bf_hi(t.y);
                        o1[0] += bf_lo(t.z); o1[1] += bf_hi(t.z); o1[2] += bf_lo(t.w); o1[3] += bf_hi(t.w); }
                    wv[bj] = pack8(o0, o1); }
                store_rows16(stg + (wr * 4 + wc) * EPI_STG_WAVE, (WHICH == 0 ? T : O) + off - (size_t)fr * 1024 - 8 * fq, 1024, fr, fq, wv[0], wv[1]); }
        }
    }
};
struct EpiOut {
    static constexpr bool PERM = true, AFTER_DRAIN = false;
    const float* x; float* h2; bf16_t* h2b; float* ss; PG8_LAS unsigned char* stg;
    __device__ __forceinline__ void operator()(const f32x4 (&acc)[2][2][4][2], const Unit& u, int wr, int wc, int fr, int fq) const {
        const int row0 = u.pm * BM + wr * 64 + fr, col0 = u.pn * BM + wc * 64 + 8 * fq;
#pragma unroll
        for (int ai = 0; ai < 2; ++ai) {
            f32x4 xa[4][2], xb[4][2];
#pragma unroll
            for (int m = 0; m < 4; ++m) { const size_t off = (size_t)(row0 + ai * HALF + m * 16) * 1024 + col0;
#pragma unroll
                for (int bj = 0; bj < 2; ++bj) { xa[m][bj] = *(const f32x4*)(x + off + bj * 32); xb[m][bj] = *(const f32x4*)(x + off + bj * 32 + 4); } }
#pragma unroll
            for (int m = 0; m < 4; ++m) { const int R = row0 + ai * HALF + m * 16; const size_t off = (size_t)R * 1024 + col0; float q = 0.f;
                u32x4 wv[2];
#pragma unroll
                for (int bj = 0; bj < 2; ++bj) { const f32x4 o0 = xa[m][bj] + acc[ai][bj][m][0], o1 = xb[m][bj] + acc[ai][bj][m][1];
                    wv[bj] = pack8(o0, o1);
                    q += (o0[0] * o0[0] + o0[1] * o0[1]) + (o0[2] * o0[2] + o0[3] * o0[3]) + (o1[0] * o1[0] + o1[1] * o1[1]) + (o1[2] * o1[2] + o1[3] * o1[3]); }
                store_rows16(stg + (wr * 4 + wc) * EPI_STG_WAVE, h2b + off - (size_t)fr * 1024 - 8 * fq, 1024, fr, fq, wv[0], wv[1]);
                q += __shfl_xor(q, 16); q += __shfl_xor(q, 32);
                if (fq == 0) ss[(size_t)R * 16 + u.pn * 4 + wc] = q; }
        }
    }
};
struct EpiUp {
    static constexpr bool PERM = true, AFTER_DRAIN = false;
    const float* ss; bf16_t* U; PG8_LAS unsigned char* stg;
    __device__ __forceinline__ void operator()(const f32x4 (&acc)[2][2][4][2], const Unit& u, int wr, int wc, int fr, int fq) const {
        const int row0 = u.pm * BM + wr * 64 + fr, col0 = u.pn * BM + wc * 64 + 8 * fq;
#pragma unroll
        for (int ai = 0; ai < 2; ++ai)
#pragma unroll
            for (int m = 0; m < 4; ++m) { const int R = row0 + ai * HALF + m * 16;
                u32x4 wv[2];
#pragma unroll
                for (int bj = 0; bj < 2; ++bj) { f32x4 v0 = acc[ai][bj][m][0], v1 = acc[ai][bj][m][1];
#pragma unroll
                    for (int e = 0; e < 4; ++e) { const float a = fmaxf(v0[e], 0.f), b = fmaxf(v1[e], 0.f); v0[e] = a * a; v1[e] = b * b; }
                    wv[bj] = pack8(v0, v1); }
                store_rows16(stg + (wr * 4 + wc) * EPI_STG_WAVE, U + (size_t)(R - fr) * 4096 + col0 - 8 * fq, 4096, fr, fq, wv[0], wv[1]); }
    }
};
struct EpiDown {
    static constexpr bool PERM = true, AFTER_DRAIN = false;
    const bf16_t* h2b; bf16_t* h; PG8_LAS unsigned char* stg; const float* r2a;
    __device__ __forceinline__ void operator()(const f32x4 (&acc)[2][2][4][2], const Unit& u, int wr, int wc, int fr, int fq) const {
        const int row0 = u.pm * BM + wr * 64 + fr, col0 = u.pn * BM + wc * 64 + 8 * fq;
#pragma unroll
        for (int ai = 0; ai < 2; ++ai) {
            u32x4 rv[4][2]; float r2v[4];
#pragma unroll
            for (int m = 0; m < 4; ++m) { const int R = row0 + ai * HALF + m * 16; const size_t off = (size_t)R * 1024 + col0; r2v[m] = r2a[R];
#pragma unroll
                for (int bj = 0; bj < 2; ++bj) rv[m][bj] = *(const u32x4*)(h2b + off + bj * 32); }
#pragma unroll
            for (int m = 0; m < 4; ++m) { const size_t off = (size_t)(row0 + ai * HALF + m * 16) * 1024 + col0; const float r2 = r2v[m];
                u32x4 wv[2];
#pragma unroll
                for (int bj = 0; bj < 2; ++bj) { const u32x4 r = rv[m][bj];
                    const f32x4 a = {bf_lo(r.x), bf_hi(r.x), bf_lo(r.y), bf_hi(r.y)}, b = {bf_lo(r.z), bf_hi(r.z), bf_lo(r.w), bf_hi(r.w)};
                    wv[bj] = pack8(a + acc[ai][bj][m][0] * r2, b + acc[ai][bj][m][1] * r2); }
                store_rows16(stg + (wr * 4 + wc) * EPI_STG_WAVE, h + off - (size_t)fr * 1024 - 8 * fq, 1024, fr, fq, wv[0], wv[1]); }
        }
    }
};

template <class Epi, class Sched, bool ALIGN_EPI = false, bool SP2 = false>
__device__ __forceinline__ void gemm_phase(PG8_LAS unsigned char* lds, const Gemm g, const Sched& S, const Epi& E) {
    const int tid = threadIdx.x, wid = __builtin_amdgcn_readfirstlane(tid >> 6), lane = tid & 63, wr = wid >> 2, wc = wid & 3, fr = lane & 15, fq = lane >> 4;
    const int K = g.K, nt = K / BK;
    unsigned voffA[2], voffB[2];
#pragma unroll
    for (int i = 0; i < 2; ++i) { int R, C; stage_rc(tid * 16 + i * 8192, R, C); const int Rb = Epi::PERM ? (64 * (R >> 5) + perm32(R & 31)) : R;
        voffA[i] = (unsigned)(R * K + C) * 2u; voffB[i] = (unsigned)(Rb * K + C) * 2u; }
    const size_t kstep = (size_t)(BK * 2);
    const size_t hstep = (size_t)HALF * K * 2;
    const size_t tstep = 2 * hstep;
    const size_t hstepB = Epi::PERM ? (size_t)32 * K * 2 : hstep;
    const unsigned ldsw = (unsigned)wid * 1024u;
    const int aoff = lds_byte(wr * 64 + fr, fq * 8), boff = lds_byte(wc * 32 + fr, fq * 8);
#define PG8_SA(b, h) (((b) * 2 + (h)) * HTB)
#define PG8_SB(b, h) ((4 + (b) * 2 + (h)) * HTB)
#define PG8_STAGE(bufoff, gbase, voff) do { _Pragma("unroll") for (int _i = 0; _i < 2; ++_i) \
        __builtin_amdgcn_global_load_lds((const unsigned*)((const char*)(gbase) + (voff)[_i]), (PG8_LAS unsigned*)(lds + (bufoff) + ldsw + _i * 8192), 16, 0, 0); } while (0)
#define PG8_LDA(dst, b, h) do { _Pragma("unroll") for (int m = 0; m < 4; ++m) _Pragma("unroll") for (int k = 0; k < 2; ++k) dst[m][k] = *(const PG8_LAS bf16x8*)(lds + PG8_SA(b, h) + aoff + m * 2048 + k * 1024); } while (0)
#define PG8_LDB(dst, b, h) do { _Pragma("unroll") for (int n = 0; n < 2; ++n) _Pragma("unroll") for (int k = 0; k < 2; ++k) dst[n][k] = *(const PG8_LAS bf16x8*)(lds + PG8_SB(b, h) + boff + n * 2048 + k * 1024); } while (0)
#define PG8_MMA(ai, bj, At, Bt) do { __builtin_amdgcn_s_setprio(1); _Pragma("unroll") for (int m = 0; m < 4; ++m) _Pragma("unroll") for (int n = 0; n < 2; ++n) _Pragma("unroll") for (int k = 0; k < 2; ++k) \
        acc[ai][bj][m][n] = __builtin_amdgcn_mfma_f32_16x16x32_bf16(Bt[n][k], At[m][k], acc[ai][bj][m][n], 0, 0, 0); __builtin_amdgcn_s_setprio(0); } while (0)
#define PG8_WAIT_V(n) asm volatile("s_waitcnt vmcnt(" #n ")" ::: "memory")
#define PG8_WAIT_L(n) asm volatile("s_waitcnt lgkmcnt(" #n ")" ::: "memory")
#define PG8_BAR __builtin_amdgcn_s_barrier()
#define PG8_SCHED __builtin_amdgcn_sched_barrier(0)
    Unit cur, nxt; int ui = 0;
    if (!S.next(0, cur)) return;
    f32x4 acc[2][2][4][2];
#pragma unroll
    for (int a = 0; a < 2; ++a)
#pragma unroll
        for (int b = 0; b < 2; ++b)
#pragma unroll
            for (int m = 0; m < 4; ++m)
#pragma unroll
                for (int n = 0; n < 2; ++n) acc[a][b][m][n] = (f32x4){0.f, 0.f, 0.f, 0.f};
    bf16x8 At[4][2], B0[2][2], B1[2][2];
    const char* cA = g.a_ptr(cur.pm); const char* cB = (const char*)g.Bt + (size_t)cur.pn * tstep;
    S.a_ready(cur);
    if constexpr (SP2) {
        PG8_STAGE(PG8_SB(0, 0), cB, voffB); PG8_STAGE(PG8_SB(0, 1), cB + hstepB, voffB); PG8_STAGE(PG8_SA(0, 0), cA, voffA); PG8_STAGE(PG8_SA(0, 1), cA + hstep, voffA);
        if (wr == 1) PG8_BAR;
        PG8_WAIT_V(2); PG8_BAR;
        PG8_STAGE(PG8_SB(1, 0), cB + kstep, voffB); PG8_STAGE(PG8_SA(1, 0), cA + kstep, voffA); PG8_STAGE(PG8_SB(1, 1), cB + hstepB + kstep, voffB);
        PG8_WAIT_V(6); PG8_BAR;
    } else {
        PG8_STAGE(PG8_SB(0, 0), cB, voffB); PG8_STAGE(PG8_SA(0, 0), cA, voffA); PG8_STAGE(PG8_SB(0, 1), cB + hstepB, voffB); PG8_STAGE(PG8_SA(0, 1), cA + hstep, voffA);
        if (wr == 1) PG8_BAR;
        PG8_WAIT_V(4); PG8_BAR;
        PG8_STAGE(PG8_SB(1, 0), cB + kstep, voffB); PG8_STAGE(PG8_SA(1, 0), cA + kstep, voffA); PG8_STAGE(PG8_SB(1, 1), cB + hstepB + kstep, voffB);
        PG8_WAIT_V(6); PG8_BAR;
    }
    for (;;) {
        const bool has_next = S.next(ui + 1, nxt);
        const char* nA = has_next ? g.a_ptr(nxt.pm) : cA; const char* nB = has_next ? (const char*)g.Bt + (size_t)nxt.pn * tstep : cB;
        for (int t = 0; t < nt; t += 2) {
            const bool last = (t == nt - 2);
            const char* a1 = cA + (size_t)(t + 1) * kstep;
            const char* a2 = last ? nA : cA + (size_t)(t + 2) * kstep; const char* b2 = last ? nB : cB + (size_t)(t + 2) * kstep;
            const char* a3 = a2 + kstep; const char* b3 = b2 + kstep;
            if (last && has_next) S.a_ready(nxt);
            if constexpr (SP2) {
            PG8_LDB(B0, 0, 0); PG8_LDB(B1, 0, 1); PG8_SCHED; PG8_LDA(At, 0, 0); PG8_STAGE(PG8_SA(1, 1), a1 + hstep, voffA);
            PG8_WAIT_V(8); PG8_WAIT_L(0); PG8_BAR; PG8_MMA(0, 0, At, B0); PG8_MMA(0, 1, At, B1); PG8_BAR; PG8_SCHED;
            PG8_LDA(At, 0, 1); PG8_STAGE(PG8_SB(0, 0), b2, voffB); PG8_STAGE(PG8_SB(0, 1), b2 + hstepB, voffB); PG8_STAGE(PG8_SA(0, 0), a2, voffA);
            PG8_WAIT_V(8); PG8_WAIT_L(0); PG8_BAR; PG8_MMA(1, 0, At, B0); PG8_MMA(1, 1, At, B1); PG8_BAR; PG8_SCHED;
            PG8_LDB(B0, 1, 0); PG8_LDB(B1, 1, 1); PG8_SCHED; PG8_LDA(At, 1, 0); PG8_STAGE(PG8_SA(0, 1), a2 + hstep, voffA);
            PG8_WAIT_V(8); PG8_WAIT_L(0); PG8_BAR; PG8_MMA(0, 0, At, B0); PG8_MMA(0, 1, At, B1); PG8_BAR; PG8_SCHED;
            PG8_LDA(At, 1, 1); PG8_STAGE(PG8_SB(1, 0), b3, voffB); PG8_STAGE(PG8_SB(1, 1), b3 + hstepB, voffB); PG8_STAGE(PG8_SA(1, 0), a3, voffA);
            PG8_WAIT_V(8); PG8_WAIT_L(0); PG8_BAR; PG8_MMA(1, 0, At, B0); PG8_MMA(1, 1, At, B1); PG8_BAR; PG8_SCHED;
            } else {
            PG8_LDB(B0, 0, 0); PG8_SCHED; PG8_LDA(At, 0, 0); PG8_STAGE(PG8_SA(1, 1), a1 + hstep, voffA);
            PG8_WAIT_L(8); PG8_BAR; PG8_WAIT_L(0); PG8_MMA(0, 0, At, B0); PG8_BAR; PG8_SCHED;
            PG8_LDB(B1, 0, 1); PG8_STAGE(PG8_SB(0, 0), b2, voffB);
            PG8_BAR; PG8_WAIT_L(0); PG8_MMA(0, 1, At, B1); PG8_BAR;
            PG8_LDA(At, 0, 1); PG8_STAGE(PG8_SA(0, 0), a2, voffA);
            PG8_BAR; PG8_WAIT_L(0); PG8_MMA(1, 0, At, B0); PG8_BAR; PG8_SCHED;
            PG8_STAGE(PG8_SB(0, 1), b2 + hstepB, voffB);
            PG8_WAIT_V(6); PG8_BAR; PG8_MMA(1, 1, At, B1); PG8_BAR;
            PG8_LDB(B0, 1, 0); PG8_SCHED; PG8_LDA(At, 1, 0); PG8_STAGE(PG8_SA(0, 1), a2 + hstep, voffA);
            PG8_WAIT_L(8); PG8_BAR; PG8_WAIT_L(0); PG8_MMA(0, 0, At, B0); PG8_BAR; PG8_SCHED;
            PG8_LDB(B1, 1, 1); PG8_STAGE(PG8_SB(1, 0), b3, voffB);
            PG8_BAR; PG8_WAIT_L(0); PG8_MMA(0, 1, At, B1); PG8_BAR;
            PG8_LDA(At, 1, 1); PG8_STAGE(PG8_SA(1, 0), a3, voffA);
            PG8_BAR; PG8_WAIT_L(0); PG8_MMA(1, 0, At, B0); PG8_BAR; PG8_SCHED;
            PG8_STAGE(PG8_SB(1, 1), b3 + hstepB, voffB);
            PG8_WAIT_V(6); PG8_BAR; PG8_MMA(1, 1, At, B1); PG8_BAR;
            }
        }
        if constexpr (ALIGN_EPI) { if (wr == 0) PG8_BAR; }
        if constexpr (!Epi::AFTER_DRAIN) { E(acc, cur, wr, wc, fr, fq); S.done(cur); }
        if (!has_next) break;
#pragma unroll
        for (int a = 0; a < 2; ++a)
#pragma unroll
            for (int b = 0; b < 2; ++b)
#pragma unroll
                for (int m = 0; m < 4; ++m)
#pragma unroll
                    for (int n = 0; n < 2; ++n) acc[a][b][m][n] = (f32x4){0.f, 0.f, 0.f, 0.f};
        cur = nxt; cA = nA; cB = nB; ++ui;
        if constexpr (ALIGN_EPI) { if (wr == 1) PG8_BAR; }
    }
    PG8_WAIT_V(0);
    if constexpr (!ALIGN_EPI) { if (wr == 0) PG8_BAR; }
    PG8_BAR;
    if constexpr (Epi::AFTER_DRAIN) { E.fused(acc, cur, wr, wc, fr, fq, lds, wid, lane); S.done(cur); }
#undef PG8_SA
#undef PG8_SB
#undef PG8_STAGE
#undef PG8_LDA
#undef PG8_LDB
#undef PG8_MMA
#undef PG8_WAIT_V
#undef PG8_WAIT_L
#undef PG8_BAR
#undef PG8_SCHED
}
}

#define LAS __attribute__((address_space(3)))
typedef unsigned short bf16;
typedef short bf16x8 __attribute__((ext_vector_type(8)));
typedef short s16x4 __attribute__((ext_vector_type(4)));
typedef float f32x4 __attribute__((ext_vector_type(4)));
typedef float f32x16 __attribute__((ext_vector_type(16)));
typedef unsigned u32x4 __attribute__((ext_vector_type(4)));
typedef unsigned u32x2 __attribute__((ext_vector_type(2)));
constexpr int NWAVES = 8;
constexpr int BATCH = 8, SEQ = 4096, NMETA = 16, LT = 4112, DM = 1024, DIN = 8192, FF = 4096;
constexpr int MFLAT = BATCH * LT, MP = 33024, MQ = BATCH * SEQ;
constexpr size_t MiB = 1u << 20;
constexpr size_t WS_SS = 0, WS_ROPE = 4 * MiB, WS_WIN = 6 * MiB, WS_WA = 22 * MiB, WS_WB = 24 * MiB, WS_WO = 26 * MiB, WS_WUP = 28 * MiB, WS_WDN = 36 * MiB;
constexpr size_t WS_SEC = 44 * MiB, SEC_BYTES = 65 * MiB, SEC_ELEMS = SEC_BYTES / 2;
constexpr size_t WS_HN = WS_SEC + 6 * SEC_BYTES, WS_END = WS_HN + 65 * MiB;
static_assert((size_t)MP * 1024 * 2 <= SEC_BYTES && (size_t)MQ * 4096 * 2 <= 4 * SEC_BYTES, "ws map");
constexpr size_t WS_R2 = 2 * MiB;
constexpr size_t WS_HNM = 5 * MiB + 256 * 1024;
constexpr size_t WS_BAR = 5 * MiB + 512 * 1024;
constexpr int LDS_BYTES = 131072 + 1024 + 8 * 16 * 144, LDS_BARW = 131072 + 512;
constexpr float LOG2E = 1.4426950408889634f, LN2 = 0.6931471805599453f, EPS = 1e-6f;

struct Frame {
    LAS unsigned char* lds; int tid, lane, wave, vcu, G;
    const float* in[16]; float* out; unsigned char* ws;
};
__device__ __forceinline__ float wave_sum(float v) {
#pragma unroll
    for (int o = 1; o < 64; o <<= 1) v += __shfl_xor(v, o);
    return v;
}
__device__ __forceinline__ unsigned cvtpk(float lo, float hi) { return pg8::cvt_pk_bf16(lo, hi); }

template <bool ROPEPERM> __device__ __forceinline__ void p0_transpose_item(const float* W, int K, int N, bf16* WT, const float* gk, LAS float* scr, int item, int lane) {
    const int nblk = N / 32, kb = item / nblk, nb = item % nblk, k0 = 64 * kb, n0 = 32 * nb;
    int src = n0 + (lane & 31);
    if (ROPEPERM && src < 2048) { const int w = src & 63; src = (src & ~63) + (w >> 1) + 32 * (w & 1); }
    float wv_[32];
#pragma unroll
    for (int i = 0; i < 32; ++i) { const int kk = 2 * i + (lane >> 5); wv_[i] = W[(size_t)(k0 + kk) * N + src]; }
#pragma unroll
    for (int i = 0; i < 32; ++i) { const int kk = 2 * i + (lane >> 5); float v = wv_[i]; if (gk) v *= gk[k0 + kk]; scr[kk * 33 + (lane & 31)] = v; }
    asm volatile("s_waitcnt lgkmcnt(0)" ::: "memory");
    const int c = lane & 7;
#pragma unroll
    for (int j = 0; j < 4; ++j) { const int n = (lane >> 3) + 8 * j; const LAS float* s = scr + (8 * c) * 33 + n;
        u32x4 o; o.x = cvtpk(s[0 * 33], s[1 * 33]); o.y = cvtpk(s[2 * 33], s[3 * 33]); o.z = cvtpk(s[4 * 33], s[5 * 33]); o.w = cvtpk(s[6 * 33], s[7 * 33]);
        *(u32x4*)(WT + (size_t)(n0 + n) * K + k0 + 8 * c) = o; }
    asm volatile("s_waitcnt lgkmcnt(0)" ::: "memory");
}
__device__ __forceinline__ void p0_prologue(const Frame& F) {
    LAS float* scr = (LAS float*)(F.lds + F.wave * 16384);
    const int gw = F.vcu * NWAVES + F.wave, NGW = F.G * NWAVES;
    unsigned char* ws = F.ws;
    constexpr int I_IN = 16 * 256, I_SQ = 16 * 32, I_UP = 16 * 128, I_DN = 64 * 32, NITEMS = I_IN + 3 * I_SQ + I_UP + I_DN;
    for (int it = gw; it < NITEMS; it += NGW) {
        int r = it;
        if (r < I_IN) { p0_transpose_item<true>(F.in[3], DM, DIN, (bf16*)(ws + WS_WIN), nullptr, scr, r, F.lane); continue; } r -= I_IN;
        if (r < I_SQ) { p0_transpose_item<false>(F.in[9], DM, DM, (bf16*)(ws + WS_WA), nullptr, scr, r, F.lane); continue; } r -= I_SQ;
        if (r < I_SQ) { p0_transpose_item<false>(F.in[10], DM, DM, (bf16*)(ws + WS_WB), nullptr, scr, r, F.lane); continue; } r -= I_SQ;
        if (r < I_SQ) { p0_transpose_item<false>(F.in[11], DM, DM, (bf16*)(ws + WS_WO), nullptr, scr, r, F.lane); continue; } r -= I_SQ;
        if (r < I_UP) { p0_transpose_item<false>(F.in[13], DM, FF, (bf16*)(ws + WS_WUP), F.in[12], scr, r, F.lane); continue; } r -= I_UP;
        p0_transpose_item<false>(F.in[14], FF, DM, (bf16*)(ws + WS_WDN), nullptr, scr, r, F.lane);
    }
    bf16* HN = (bf16*)(ws + WS_HN); bf16* HNM = (bf16*)(ws + WS_HNM);
    const f32x4* g4 = (const f32x4*)F.in[2] + F.lane;
    constexpr int NR = 4;
    for (int R0 = gw; R0 < MQ + NMETA; R0 += NR * NGW) {
        f32x4 v[NR][4]; float sq[NR]; bool has[NR]; int Rr[NR];
#pragma unroll
        for (int rr = 0; rr < NR; ++rr) { const int R = R0 + rr * NGW; has[rr] = R < MQ + NMETA; Rr[rr] = has[rr] ? R : R0;
            const f32x4* xr = (const f32x4*)(Rr[rr] < MQ ? F.in[0] + (size_t)Rr[rr] * DM : F.in[1] + (size_t)(Rr[rr] - MQ) * DM) + F.lane;
#pragma unroll
            for (int j = 0; j < 4; ++j) v[rr][j] = xr[64 * j]; }
#pragma unroll
        for (int rr = 0; rr < NR; ++rr) { float s = 0.f;
#pragma unroll
            for (int j = 0; j < 4; ++j) s += (v[rr][j].x * v[rr][j].x + v[rr][j].y * v[rr][j].y) + (v[rr][j].z * v[rr][j].z + v[rr][j].w * v[rr][j].w);
            sq[rr] = s; }
#pragma unroll
        for (int rr = 0; rr < NR; ++rr) { const float rstd = 1.0f / sqrtf(wave_sum(sq[rr]) * (1.0f / DM) + EPS);
            u32x2* o8 = (u32x2*)(Rr[rr] < MQ ? HN + (size_t)Rr[rr] * DM : HNM + (size_t)(Rr[rr] - MQ) * DM) + F.lane;
            if (has[rr]) {
#pragma unroll
                for (int j = 0; j < 4; ++j) { const f32x4 g = g4[64 * j]; o8[64 * j] = (u32x2){cvtpk(v[rr][j].x * rstd * g.x, v[rr][j].y * rstd * g.y), cvtpk(v[rr][j].z * rstd * g.z, v[rr][j].w * rstd * g.w)}; } } }
    }
    float* rope = (float*)(ws + WS_ROPE);
    for (int idx = (F.vcu * NWAVES * 64) + F.tid; idx < LT * 32; idx += F.G * NWAVES * 64) {
        const int pos = idx >> 5, i = idx & 31;
        const float inv = (float)exp(-(double)i * (9.210340371976184 / 32.0));
        const float ang = (float)pos * inv;
        const double a = (double)ang; const double k = rint(a * 0.15915494309189535); const double rr = fma(-k, 6.283185307179586, a) - k * 2.4492935982947064e-16;
        const float rf = (float)rr;
        rope[2 * idx] = cosf(rf); rope[2 * idx + 1] = sinf(rf);
    }
}

__device__ __forceinline__ int crow(int r, int hi) { return (r & 3) + 8 * (r >> 2) + 4 * hi; }
typedef short v4i16_t __attribute__((ext_vector_type(4)));
__device__ __forceinline__ s16x4 vtr(const LAS unsigned char* p) { return __builtin_bit_cast(s16x4, __builtin_amdgcn_ds_read_tr16_b64_v4i16((LAS v4i16_t*)p)); }
#define MFMA32(a, b, c) __builtin_amdgcn_mfma_f32_32x32x16_bf16((a), (b), (c), 0, 0, 0)
__device__ __forceinline__ bf16x8 pack_step(const f32x16& x, int s) {
    u32x4 p; p.x = cvtpk(x[8 * s], x[8 * s + 1]); p.y = cvtpk(x[8 * s + 2], x[8 * s + 3]); p.z = cvtpk(x[8 * s + 4], x[8 * s + 5]); p.w = cvtpk(x[8 * s + 6], x[8 * s + 7]);
    return __builtin_bit_cast(bf16x8, p);
}
#define VFRAG(ptr, off0, STR) ({ const s16x4 lo_ = vtr((ptr) + (off0)); const s16x4 hi_ = vtr((ptr) + (off0) + 8 * (STR)); (bf16x8){lo_[0], lo_[1], lo_[2], lo_[3], hi_[0], hi_[1], hi_[2], hi_[3]}; })

constexpr int DK_STR = 272, DV_STR = 320, DK_BUF = 64 * DK_STR, DV_BUF = 64 * DV_STR, D_KOFF = 0, D_VOFF = 2 * DK_BUF;
__device__ __forceinline__ void diff_unit(const Frame& F, int b, int h, int qi, float lam, int dry) {
    LAS unsigned char* lds = F.lds;
    const int tid = F.tid, lane = F.lane, wid = F.wave, r32 = lane & 31, hi = lane >> 5;
    const int map = wid >> 2, wq = wid & 3;
    const size_t rowbase = (size_t)b * LT;
    const int tq0 = NMETA + 128 * qi, tqw = tq0 + 32 * wq, tq = tqw + r32;
    bf16* QA = (bf16*)(F.ws + WS_SEC); const bf16* KA = QA + SEC_ELEMS; const bf16* VA = QA + 2 * SEC_ELEMS;
    bf16x8 qf[4];
    { const bf16* qp = QA + (rowbase + tq) * 1024 + 128 * h + 64 * map + 8 * hi;
#pragma unroll
      for (int ks = 0; ks < 4; ++ks) qf[ks] = *(const bf16x8*)(qp + 16 * ks); }
    const int srow = tid >> 4, sc16 = tid & 15;
    const bf16* kg = KA + (rowbase + srow) * 1024 + 128 * h + sc16 * 8;
    const bf16* vg = VA + (rowbase + srow) * 1024 + 128 * h + sc16 * 8;
    const int klds = D_KOFF + srow * DK_STR + sc16 * 16, vlds = D_VOFF + srow * DV_STR + sc16 * 16;
    u32x4 st0, st1, st2, st3;
#define D_LOAD(key0) do { st0 = *(const u32x4*)(kg + (size_t)(key0) * 1024); st1 = *(const u32x4*)(kg + (size_t)((key0) + 32) * 1024); st2 = *(const u32x4*)(vg + (size_t)(key0) * 1024); st3 = *(const u32x4*)(vg + (size_t)((key0) + 32) * 1024); } while (0)
#define D_STORE(buf) do { *(LAS u32x4*)(lds + klds + (buf) * DK_BUF) = st0; *(LAS u32x4*)(lds + klds + (buf) * DK_BUF + 32 * DK_STR) = st1; *(LAS u32x4*)(lds + vlds + (buf) * DV_BUF) = st2; *(LAS u32x4*)(lds + vlds + (buf) * DV_BUF + 32 * DV_STR) = st3; } while (0)
    const int nt = 2 * qi + 3;
    __syncthreads();
    D_LOAD(0); D_STORE(0);
    __syncthreads();
    f32x16 O[4];
#pragma unroll
    for (int dt = 0; dt < 4; ++dt)
#pragma unroll
        for (int r = 0; r < 16; ++r) O[dt][r] = 0.f;
    float ms = -INFINITY, lsum = 0.f;
    const int kra = D_KOFF + r32 * DK_STR + map * 128 + hi * 16;
    const int vra = D_VOFF + (4 * hi + ((lane & 15) >> 2)) * DV_STR + (16 * ((lane >> 4) & 1) + 4 * (lane & 3)) * 2;
    for (int it = 0; it < nt; ++it) {
        const int key0 = it == 0 ? 0 : NMETA + 64 * (it - 1);
        if (it + 1 < nt) D_LOAD(NMETA + 64 * it);
        const bool meta = (it == 0);
        if (meta || key0 <= tqw + 31) {
            const LAS unsigned char* kb = lds + kra + (it & 1) * DK_BUF;
            const LAS unsigned char* vb = lds + vra + (it & 1) * DV_BUF;
            f32x16 s0, s1;
#pragma unroll
            for (int r = 0; r < 16; ++r) { s0[r] = 0.f; s1[r] = 0.f; }
            bf16x8 vpre0 = VFRAG(vb, 0, DV_STR), vpre1 = VFRAG(vb, 64, DV_STR), vpre2 = VFRAG(vb, 128, DV_STR), vpre3 = VFRAG(vb, 192, DV_STR);
            bf16x8 vprf0 = VFRAG(vb, 16 * DV_STR, DV_STR), vprf1 = VFRAG(vb, 16 * DV_STR + 64, DV_STR);
            __builtin_amdgcn_s_setprio(1);
#pragma unroll
            for (int ks = 0; ks < 4; ++ks) { const bf16x8 k0 = *(const LAS bf16x8*)(kb + ks * 32); s0 = MFMA32(k0, qf[ks], s0); }
            if (!meta) {
#pragma unroll
                for (int ks = 0; ks < 4; ++ks) { const bf16x8 k1 = *(const LAS bf16x8*)(kb + 32 * DK_STR + ks * 32); s1 = MFMA32(k1, qf[ks], s1); }
            }
            __builtin_amdgcn_s_setprio(0);
            if (meta) {
#pragma unroll
                for (int r = 8; r < 16; ++r) s0[r] = -INFINITY;
#pragma unroll
                for (int r = 0; r < 16; ++r) s1[r] = -INFINITY;
            } else if (key0 + 63 > tqw) {
#pragma unroll
                for (int r = 0; r < 16; ++r) { const int c = (r & 3) + 8 * (r >> 2), lim = tq - key0 - 4 * hi; if (c > lim) s0[r] = -INFINITY; if (c + 32 > lim) s1[r] = -INFINITY; }
            }
            float mx = fmaxf(s0[0], s1[0]);
#pragma unroll
            for (int r = 1; r < 16; ++r) mx = fmaxf(mx, fmaxf(s0[r], s1[r]));
            mx = fmaxf(mx, __shfl_xor(mx, 32));
            const float mxs = mx * LOG2E;
            if (__any(mxs > ms + 8.0f)) {
                const float msn = fmaxf(ms, mxs); const float f = __builtin_amdgcn_exp2f(ms - msn); lsum *= f; ms = msn;
#pragma unroll
                for (int dt = 0; dt < 4; ++dt)
#pragma unroll
                    for (int r = 0; r < 16; ++r) O[dt][r] *= f;
            }
            float ps = 0.f;
#pragma unroll
            for (int r = 0; r < 16; ++r) { s0[r] = __builtin_amdgcn_exp2f(s0[r] * LOG2E - ms); ps += s0[r]; }
            if (!meta) {
#pragma unroll
                for (int r = 0; r < 16; ++r) { s1[r] = __builtin_amdgcn_exp2f(s1[r] * LOG2E - ms); ps += s1[r]; }
            }
            lsum += ps;
            __builtin_amdgcn_s_setprio(1);
            { const bf16x8 pf = pack_step(s0, 0);
              O[0] = MFMA32(vpre0, pf, O[0]); O[1] = MFMA32(vpre1, pf, O[1]); O[2] = MFMA32(vpre2, pf, O[2]); O[3] = MFMA32(vpre3, pf, O[3]); }
            if (!meta) {
                { const bf16x8 pf = pack_step(s0, 1);
                  O[0] = MFMA32(vprf0, pf, O[0]); O[1] = MFMA32(vprf1, pf, O[1]);
#pragma unroll
                  for (int dt = 2; dt < 4; ++dt) { const bf16x8 vf = VFRAG(vb, 16 * DV_STR + 64 * dt, DV_STR); O[dt] = MFMA32(vf, pf, O[dt]); } }
#pragma unroll
                for (int s2 = 0; s2 < 2; ++s2) { const bf16x8 pf = pack_step(s1, s2);
#pragma unroll
                    for (int dt = 0; dt < 4; ++dt) { const bf16x8 vf = VFRAG(vb, (32 + 16 * s2) * DV_STR + 64 * dt, DV_STR); O[dt] = MFMA32(vf, pf, O[dt]); } }
            }
            __builtin_amdgcn_s_setprio(0);
        }
        if (it + 1 < nt) D_STORE((it + 1) & 1);
        __syncthreads();
    }
#undef D_LOAD
#undef D_STORE
    const float lt = lsum + __shfl_xor(lsum, 32);
    LAS float* xch = (LAS float*)lds + (size_t)(wq * 64) * 64 + lane;
    if (map == 1) { const float sc = lam / lt;
#pragma unroll
        for (int dt = 0; dt < 4; ++dt)
#pragma unroll
            for (int r = 0; r < 16; ++r) xch[(dt * 16 + r) * 64] = O[dt][r] * sc; }
    __syncthreads();
    if (map == 0 && !dry) { const float il = 1.0f / lt; float q = 0.f;
        f32x4 gv[4][4];
#pragma unroll
        for (int dt = 0; dt < 4; ++dt)
#pragma unroll
            for (int c = 0; c < 4; ++c) gv[dt][c] = *(const f32x4*)(F.in[8] + 32 * dt + 8 * c + 4 * hi);
#pragma unroll
        for (int dt = 0; dt < 4; ++dt)
#pragma unroll
            for (int r = 0; r < 16; ++r) { const float o = O[dt][r] * il - xch[(dt * 16 + r) * 64]; O[dt][r] = o; q += o * o; }
        q += __shfl_xor(q, 32);
        const float rs = 0.8f / sqrtf(q * (1.0f / 128.0f) + EPS);
        LAS unsigned char* stg = lds + (size_t)wq * (64 * 64 * 4);
        const float* sg = F.in[8];
#pragma unroll
        for (int dt = 0; dt < 4; ++dt)
#pragma unroll
            for (int c = 0; c < 4; ++c) { const int d = 32 * dt + 8 * c + 4 * hi; const f32x4 g = gv[dt][c];
                *(LAS u32x2*)(stg + r32 * 272 + 2 * d) = (u32x2){cvtpk(O[dt][4 * c] * rs * g.x, O[dt][4 * c + 1] * rs * g.y), cvtpk(O[dt][4 * c + 2] * rs * g.z, O[dt][4 * c + 3] * rs * g.w)}; }
        bf16* ob = QA + (rowbase + tqw) * 1024 + 128 * h;
#pragma unroll
        for (int j = 0; j < 8; ++j) { const int id = lane + 64 * j, row = id >> 4, ch = id & 15; const u32x4 v = *(const LAS u32x4*)(stg + row * 272 + ch * 16); *(u32x4*)(ob + (size_t)row * 1024 + ch * 8) = v; }
    }
}

constexpr int SK_STR = 144, SV_STR = 192, SK_BUF = 128 * SK_STR, SV_BUF = 128 * SV_STR, S_KOFF = 0, S_VOFF = 2 * SK_BUF;
__device__ __forceinline__ void sb_unit(const Frame& F, int b, int hd, int qi, int dry) {
    LAS unsigned char* lds = F.lds;
    const int tid = F.tid, lane = F.lane, wid = F.wave, r32 = lane & 31, hi = lane >> 5;
    const size_t rowbase = (size_t)b * LT;
    const int tq0 = NMETA + 256 * qi, tqw = tq0 + 32 * wid, tq = tqw + r32;
    bf16* QB = (bf16*)(F.ws + WS_SEC) + 3 * SEC_ELEMS; const bf16* KB = QB + SEC_ELEMS; const bf16* VB = QB + 2 * SEC_ELEMS;
    bf16x8 qf[4];
    { const bf16* qp = QB + (rowbase + tq) * 1024 + 64 * hd + 8 * hi;
#pragma unroll
      for (int ks = 0; ks < 4; ++ks) qf[ks] = *(const bf16x8*)(qp + 16 * ks); }
    const int srow = tid >> 3, sc16 = tid & 7;
    const bf16* kg = KB + (rowbase + srow) * 1024 + 64 * hd + sc16 * 8;
    const bf16* vg = VB + (rowbase + srow) * 1024 + 64 * hd + sc16 * 8;
    const int klds = S_KOFF + srow * SK_STR + sc16 * 16, vlds = S_VOFF + srow * SV_STR + sc16 * 16;
    u32x4 st0, st1, st2, st3;
#define S_LOAD(key0) do { st0 = *(const u32x4*)(kg + (size_t)(key0) * 1024); st1 = *(const u32x4*)(kg + (size_t)((key0) + 64) * 1024); st2 = *(const u32x4*)(vg + (size_t)(key0) * 1024); st3 = *(const u32x4*)(vg + (size_t)((key0) + 64) * 1024); } while (0)
#define S_STORE(buf) do { *(LAS u32x4*)(lds + klds + (buf) * SK_BUF) = st0; *(LAS u32x4*)(lds + klds + (buf) * SK_BUF + 64 * SK_STR) = st1; \
        *(LAS u32x4*)(lds + vlds + (buf) * SV_BUF) = st2; *(LAS u32x4*)(lds + vlds + (buf) * SV_BUF + 64 * SV_STR) = st3; } while (0)
    const int jmax = 2 * qi + 1, nt = jmax + 2;
    __syncthreads();
    S_LOAD(NMETA + 128 * jmax); S_STORE(0);
    __syncthreads();
    f32x16 O[2];
#pragma unroll
    for (int dt = 0; dt < 2; ++dt)
#pragma unroll
        for (int r = 0; r < 16; ++r) O[dt][r] = 0.f;
    float C = 0.f;
    bool dead = false;
    constexpr float SB_DEAD = -150.0f;
    LAS int* flags = (LAS int*)(lds + S_VOFF + 2 * SV_BUF);
    const int kra = S_KOFF + r32 * SK_STR + hi * 16;
    const int vra = S_VOFF + (4 * hi + ((lane & 15) >> 2)) * SV_STR + (16 * ((lane >> 4) & 1) + 4 * (lane & 3)) * 2;
    for (int it = 0; it < nt; ++it) {
        const bool meta = (it > jmax);
        const int key0 = meta ? 0 : NMETA + 128 * (jmax - it);
        if (it + 1 < nt) { const int nk = (it + 1 > jmax) ? 0 : NMETA + 128 * (jmax - it - 1); S_LOAD(nk); }
        if (!dead && (meta || key0 < tqw + 31)) {
            const LAS unsigned char* kb = lds + kra + (it & 1) * SK_BUF;
            const LAS unsigned char* vb = lds + vra + (it & 1) * SV_BUF;
#define SB_HALF(KO)  do { f32x16 S_, om_; \
                _Pragma("unroll") for (int r = 0; r < 16; ++r) S_[r] = 0.f; \
                _Pragma("unroll") for (int ks = 0; ks < 4; ++ks) { const bf16x8 kf_ = *(const LAS bf16x8*)(kb + (KO) * SK_STR + ks * 32); S_ = MFMA32(kf_, qf[ks], S_); } \
                const int lim_ = (meta ? NMETA : tq) - key0 - (KO) - 4 * hi;     \
                  \
                const bf16x8 vq0_ = VFRAG(vb, (KO) * SV_STR, SV_STR), vq1_ = VFRAG(vb, (KO) * SV_STR + 64, SV_STR), vq2_ = VFRAG(vb, ((KO) + 16) * SV_STR, SV_STR), vq3_ = VFRAG(vb, ((KO) + 16) * SV_STR + 64, SV_STR); \
                  \
                  \
                  \
                const float sc_ = __builtin_amdgcn_exp2f(run); \
                _Pragma("unroll") for (int r = 0; r < 16; ++r) { const float z = fmaxf(S_[r], -126.0f); const bool valid = (r & 3) + 8 * (r >> 2) < lim_; const float e = __builtin_amdgcn_exp2f(-z); \
                    const float bt = __builtin_amdgcn_rcpf(1.0f + e); om_[r] = valid ? e * bt : 1.0f; S_[r] = valid ? bt * sc_ : 0.f; } \
                float rp_ = 1.0f; \
                _Pragma("unroll") for (int c = 3; c >= 0; --c) { const float cs = (om_[4 * c] * om_[4 * c + 1]) * (om_[4 * c + 2] * om_[4 * c + 3]); const float co = __shfl_xor(cs, 32); \
                    const float e3 = rp_ * (hi == 0 ? co : 1.0f), e2 = e3 * om_[4 * c + 3], e1 = e2 * om_[4 * c + 2], e0 = e1 * om_[4 * c + 1]; \
                    S_[4 * c + 3] *= e3; S_[4 * c + 2] *= e2; S_[4 * c + 1] *= e1; S_[4 * c] *= e0; \
                    rp_ *= cs * co; } \
                run += __builtin_amdgcn_logf(rp_);     \
                { const bf16x8 pf0_ = pack_step(S_, 0), pf1_ = pack_step(S_, 1); \
                  O[0] = MFMA32(vq0_, pf0_, O[0]); O[1] = MFMA32(vq1_, pf0_, O[1]); O[0] = MFMA32(vq2_, pf1_, O[0]); O[1] = MFMA32(vq3_, pf1_, O[1]); } \
            } while (0)
            float run = C;
            if (!meta && key0 + 96 < tqw + 31) SB_HALF(96);
            if (!meta && key0 + 64 < tqw + 31 && __any(run >= SB_DEAD)) SB_HALF(64);
            if (!meta && key0 + 32 < tqw + 31 && __any(run >= SB_DEAD)) SB_HALF(32);
            if (__any(run >= SB_DEAD)) SB_HALF(0);
            C = run; dead = !__any(C >= SB_DEAD);
#undef SB_HALF
        }
        if (it + 1 < nt) S_STORE((it + 1) & 1);
        if (lane == 0) flags[(it & 1) * 8 + wid] = dead ? 1 : 0;
        __syncthreads();
        if (!__any(flags[(it & 1) * 8 + (lane & 7)] == 0)) break;
    }
#undef S_LOAD
#undef S_STORE
    if (dry) return;
    LAS unsigned char* stg = lds + (size_t)wid * (32 * 144);
#pragma unroll
    for (int dt = 0; dt < 2; ++dt)
#pragma unroll
        for (int c = 0; c < 4; ++c) { const int d = 32 * dt + 8 * c + 4 * hi;
            *(LAS u32x2*)(stg + r32 * 144 + 2 * d) = (u32x2){cvtpk(O[dt][4 * c], O[dt][4 * c + 1]), cvtpk(O[dt][4 * c + 2], O[dt][4 * c + 3])}; }
    bf16* ob = QB + (rowbase + tqw) * 1024 + 64 * hd;
#pragma unroll
    for (int j = 0; j < 4; ++j) { const int id = lane + 64 * j, row = id >> 3, ch = id & 7; const u32x4 v = *(const LAS u32x4*)(stg + row * 144 + ch * 16); *(u32x4*)(ob + (size_t)row * 1024 + ch * 8) = v; }
}
__device__ __forceinline__ void attn_phase(const Frame& F) {
    const float a1 = wave_sum(F.in[4][F.lane] * F.in[5][F.lane]), a2 = wave_sum(F.in[6][F.lane] * F.in[7][F.lane]);
    const float lam = expf(a1) - expf(a2) + 0.2f;
    for (int rep = PROBE_DIFF ? 0 : 1; rep < 2; ++rep)
    for (int pidx = F.vcu; pidx < 1024; pidx += F.G) {
        const int bh = pidx >> 4, p = pidx & 15;
        diff_unit(F, bh >> 3, bh & 7, p, lam, rep == 0);
        diff_unit(F, bh >> 3, bh & 7, 31 - p, lam, rep == 0);
    }
    for (int rep = PROBE_SB ? 0 : 1; rep < 2; ++rep)
    for (int pidx = F.vcu; pidx < 1024; pidx += F.G) {
        const int bh = pidx >> 3, p = pidx & 7;
        sb_unit(F, bh >> 4, bh & 15, p, rep == 0);
        sb_unit(F, bh >> 4, bh & 15, 15 - p, rep == 0);
    }
    __syncthreads();
}
__device__ __forceinline__ void final_norm(const Frame& F) {
    const int gw = F.vcu * NWAVES + F.wave, NGW = F.G * NWAVES;
    const f32x4* g4 = (const f32x4*)F.in[15] + F.lane;
    const bf16* H3 = (const bf16*)(F.ws + WS_SEC) + 5 * SEC_ELEMS;
    constexpr int NR = 4;
    for (int R0 = gw; R0 < MQ; R0 += NR * NGW) {
        u32x2 w[NR][4]; bool has[NR]; int Rr[NR];
#pragma unroll
        for (int rr = 0; rr < NR; ++rr) { const int R = R0 + rr * NGW; has[rr] = R < MQ; Rr[rr] = has[rr] ? R : R0; const u32x2* hr = (const u32x2*)(H3 + (size_t)Rr[rr] * DM) + F.lane;
#pragma unroll
            for (int j = 0; j < 4; ++j) w[rr][j] = hr[64 * j]; }
#pragma unroll
        for (int rr = 0; rr < NR; ++rr) { f32x4 v[4]; float s = 0.f;
#pragma unroll
            for (int j = 0; j < 4; ++j) { v[j] = (f32x4){pg8::bf_lo(w[rr][j].x), pg8::bf_hi(w[rr][j].x), pg8::bf_lo(w[rr][j].y), pg8::bf_hi(w[rr][j].y)}; s += (v[j].x * v[j].x + v[j].y * v[j].y) + (v[j].z * v[j].z + v[j].w * v[j].w); }
            const float rstd = 1.0f / sqrtf(wave_sum(s) * (1.0f / DM) + EPS);
            f32x4* xr = (f32x4*)(F.out + (size_t)Rr[rr] * DM) + F.lane;
            if (has[rr]) {
#pragma unroll
                for (int j = 0; j < 4; ++j) xr[64 * j] = v[j] * rstd * g4[64 * j]; } }
    }
}

__device__ __forceinline__ void meta_proj(const Frame& F, int v) {
    const int lane = F.lane, w = F.wave, cbk = w & 1, kq = w >> 1, n0 = 32 * v;
    const bf16* ap = (const bf16*)(F.ws + WS_HNM) + (size_t)(lane & 15) * DM + 256 * kq + 8 * (lane >> 4);
    const bf16* bp = (const bf16*)(F.ws + WS_WIN) + (size_t)(n0 + 16 * cbk + (lane & 15)) * DM + 256 * kq + 8 * (lane >> 4);
    bf16x8 af[8], bfr[8];
#pragma unroll
    for (int ks = 0; ks < 8; ++ks) { af[ks] = *(const bf16x8*)(ap + 32 * ks); bfr[ks] = *(const bf16x8*)(bp + 32 * ks); }
    f32x4 acc = {0.f, 0.f, 0.f, 0.f};
#pragma unroll
    for (int ks = 0; ks < 8; ++ks) acc = __builtin_amdgcn_mfma_f32_16x16x32_bf16(af[ks], bfr[ks], acc, 0, 0, 0);
    LAS f32x4* red = (LAS f32x4*)F.lds;
    red[(kq * 2 + cbk) * 64 + lane] = acc;
    __syncthreads();
    if (kq == 0) {
        const f32x4 s = (red[(0 * 2 + cbk) * 64 + lane] + red[(1 * 2 + cbk) * 64 + lane]) + (red[(2 * 2 + cbk) * 64 + lane] + red[(3 * 2 + cbk) * 64 + lane]);
        const int c = n0 + 16 * cbk + (lane & 15), sec = c >> 10, cs = c & 1023;
        bf16* base = (bf16*)(F.ws + WS_SEC) + (size_t)sec * SEC_ELEMS + cs;
        const float* rope = (const float*)(F.ws + WS_ROPE);
#pragma unroll
        for (int i = 0; i < 4; ++i) { const int t = 4 * (lane >> 4) + i; float val = s[i];
            if (sec < 2) {
                const float o = __shfl_xor(val, 1); const int ip = (cs & 63) >> 1; const float cc = rope[(t * 32 + ip) * 2], sn = rope[(t * 32 + ip) * 2 + 1];
                val = (lane & 1) ? val * cc + o * sn : val * cc - o * sn;
                if (sec == 0) val *= 0.125f;
            } else if (sec == 3) val *= 0.125f * LOG2E;
            const unsigned short hb = (unsigned short)(cvtpk(val, 0.f) & 0xffffu);
#pragma unroll
            for (int b = 0; b < BATCH; ++b) base[((size_t)b * LT + t) * 1024] = hb; }
    }
    __syncthreads();
}

#define XB_TMO      128
#define XB_XCNT(j)  (256  + 64 * (j))
#define XB_XSUB(j)  (1280 + 64 * (j))
#define XB_XGEN(j)  (2304 + 64 * (j))
#define XB_TOP      3328
#define XB_TOPGEN   3392
#define XCD_BAR_WORDS 3456
#define XB_SPIN_CAP (1u << 18)

__device__ __forceinline__ unsigned xb_ld(unsigned* p)              { return __hip_atomic_load(p, __ATOMIC_RELAXED, __HIP_MEMORY_SCOPE_AGENT); }
__device__ __forceinline__ unsigned xb_add(unsigned* p, unsigned v) { return __hip_atomic_fetch_add(p, v, __ATOMIC_RELAXED, __HIP_MEMORY_SCOPE_AGENT); }
__device__ __forceinline__ unsigned xb_xcc_id() { return (unsigned)__builtin_amdgcn_s_getreg((3 << 11) | 20) & 0xFu; }
#define XB_SPIN(cond, bar) do { unsigned _sp = 0; while (cond) { __builtin_amdgcn_s_sleep(1); \
    if ((++_sp & 255u) == 0u) { if (xb_ld(&(bar)[XB_TMO])) break; if (_sp > XB_SPIN_CAP) { atomicAdd(&(bar)[XB_TMO], 1u); break; } } } } while (0)

struct XcdBarrier {
    unsigned* bar; unsigned x;
    volatile LAS unsigned* st;
};

__device__ __forceinline__ XcdBarrier xcd_barrier_post(unsigned* bar, volatile LAS unsigned* st) {
    XcdBarrier b; b.bar = bar; b.x = xb_xcc_id(); b.st = st;
    if (threadIdx.x == 0) (void)xb_add(&bar[XB_XCNT(b.x)], 1u);
    return b;
}
__device__ __forceinline__ void xcd_barrier_complete(unsigned* bar, unsigned x, unsigned& nloc, unsigned& nx) {
    const unsigned G = gridDim.x * gridDim.y * gridDim.z;
    unsigned sum, cnt, mine, sp = 0u;
    for (;;) {
        sum = 0u; cnt = 0u; mine = 0u;
#pragma unroll
        for (unsigned j = 0; j < 16; ++j) { const unsigned c = xb_ld(&bar[XB_XCNT(j)]); sum += c; cnt += (c > 0u) ? 1u : 0u; mine = (j == x) ? c : mine; }
        if (sum == G) break;
        __builtin_amdgcn_s_sleep(1);
        if ((++sp & 255u) == 0u) { if (xb_ld(&bar[XB_TMO])) break; if (sp > XB_SPIN_CAP) { atomicAdd(&bar[XB_TMO], 1u); break; } }
    }
    nloc = mine > 0u ? mine : 1u; nx = cnt > 0u ? cnt : 1u;
}

__device__ __forceinline__ void xcd_barrier(const XcdBarrier& b) {
    asm volatile("s_waitcnt vmcnt(0)" ::: "memory");
    __syncthreads();
    if (threadIdx.x == 0) {
        unsigned* bar = b.bar;
        __builtin_amdgcn_s_waitcnt(0);
        unsigned nloc = b.st[0], nx = b.st[1];
        if (nloc == 0u) { xcd_barrier_complete(bar, b.x, nloc, nx); b.st[0] = nloc; b.st[1] = nx; }
        const unsigned old = xb_add(&bar[XB_XSUB(b.x)], 1u);
        const unsigned gen = old / nloc;
        if (old + 1u == (gen + 1u) * nloc) {
            __builtin_amdgcn_fence(__ATOMIC_RELEASE, "agent");
            asm volatile("s_waitcnt vmcnt(0)" ::: "memory");
            const unsigned og = xb_add(&bar[XB_TOP], 1u);
            const unsigned tg = og / nx;
            if (og + 1u == (tg + 1u) * nx) xb_add(&bar[XB_TOPGEN], 1u);
            else XB_SPIN(xb_ld(&bar[XB_TOPGEN]) == tg, bar);
            __builtin_amdgcn_fence(__ATOMIC_ACQUIRE, "agent");
            xb_add(&bar[XB_XGEN(b.x)], 1u);
            asm volatile("s_waitcnt vmcnt(0)" ::: "memory");
        } else {
            XB_SPIN(xb_ld(&bar[XB_XGEN(b.x)]) == gen, bar);
            __builtin_amdgcn_fence(__ATOMIC_ACQUIRE, "agent");
            asm volatile("s_waitcnt vmcnt(0)" ::: "memory");
        }
    }
    __syncthreads();
}

struct Args { const float* in[16]; float* out; unsigned char* ws; int ph_lo, ph_hi; };
__global__ void __launch_bounds__(NWAVES * 64, 2) mk_fwd(Args args) {
    extern __shared__ __attribute__((aligned(16))) unsigned char lds_raw[];
    cg::grid_group grid = cg::this_grid();
    Frame F;
    F.lds = (LAS unsigned char*)lds_raw;
    F.tid = threadIdx.x; F.lane = F.tid & 63; F.wave = __builtin_amdgcn_readfirstlane(F.tid >> 6);
    F.G = gridDim.x; { const int bx = blockIdx.x; F.vcu = (F.G % 8 == 0) ? (bx % 8) * (F.G / 8) + bx / 8 : bx; }
#pragma unroll
    for (int i = 0; i < 16; ++i) F.in[i] = args.in[i];
    F.out = args.out; F.ws = args.ws;
    unsigned char* ws = args.ws;
    const int lo = args.ph_lo, hi = args.ph_hi;
    volatile LAS unsigned* barst = (volatile LAS unsigned*)(F.lds + LDS_BARW);
    if (F.tid < 4) barst[F.tid] = 0u;
    __syncthreads();
    XcdBarrier xbar = xcd_barrier_post((unsigned*)(ws + WS_BAR), barst);
#define IN(k) (lo <= (k) && (k) < hi)
    if (lo > 1000) grid.sync();
#define SEAM(k) do { if (IN(k) && IN((k) + 1)) xcd_barrier(xbar); } while (0)
    bf16* SEC = (bf16*)(ws + WS_SEC);
    bf16* GATES = (bf16*)args.out;
    float* SS = (float*)(ws + WS_SS);
    if (IN(0)) p0_prologue(F);
    SEAM(0);
    if (IN(1)) {
        if (F.vcu < 192) meta_proj(F, F.vcu);
        pg8::Gemm g{(const bf16*)(ws + WS_HN), (const bf16*)(ws + WS_WIN), MQ, DIN, DM, 0}; pg8::StaticOrder S; S.init(MQ, DIN, F.G, (int)blockIdx.x);
        pg8::EpiProj E{SEC, SEC_ELEMS, GATES, (const float*)(ws + WS_ROPE), F.lds + pg8::EPI_STG_OFF};
        for (int rep = PROBE_P1 ? 0 : 1; rep < 2; ++rep)
        pg8::gemm_phase<pg8::EpiProj, pg8::StaticOrder, true, true>(F.lds, g, S, E);
    }
    SEAM(1);
    if (IN(2)) attn_phase(F);
    SEAM(2);
    if (IN(3)) {
        bf16* TMP = SEC + SEC_ELEMS; bf16* MERGED = SEC + 2 * SEC_ELEMS;
        { pg8::Gemm g{SEC, (const bf16*)(ws + WS_WA), MQ, DM, DM, 1}; pg8::StaticOrder S; S.init(MQ, DM, F.G, (int)blockIdx.x);
          pg8::EpiGate<0> E{GATES, TMP, MERGED, F.lds + pg8::EPI_STG_OFF};
          pg8::gemm_phase<pg8::EpiGate<0>, pg8::StaticOrder, true, true>(F.lds, g, S, E); }
        { pg8::Gemm g{SEC + 3 * SEC_ELEMS, (const bf16*)(ws + WS_WB), MQ, DM, DM, 1}; pg8::StaticOrder S; S.init(MQ, DM, F.G, (int)blockIdx.x);
          pg8::EpiGate<1> E{GATES + (size_t)MQ * 1024, TMP, MERGED, F.lds + pg8::EPI_STG_OFF};
          pg8::gemm_phase<pg8::EpiGate<1>, pg8::StaticOrder, true, true>(F.lds, g, S, E); }
    }
    SEAM(3);
    if (IN(4)) {
        pg8::Gemm g{SEC + 2 * SEC_ELEMS, (const bf16*)(ws + WS_WO), MQ, DM, DM, 0}; pg8::StaticOrder S; S.init(MQ, DM, F.G, (int)blockIdx.x);
        pg8::EpiOut E{F.in[0], args.out, SEC + 4 * SEC_ELEMS, SS, F.lds + pg8::EPI_STG_OFF};
        pg8::gemm_phase<pg8::EpiOut, pg8::StaticOrder, true, true>(F.lds, g, S, E);
    }
    SEAM(4);
    if (IN(5)) {
        { float* R2 = (float*)(ws + WS_R2);
          for (int R = F.vcu * (NWAVES * 64) + F.tid; R < MQ; R += F.G * NWAVES * 64) { const f32x4* sp = (const f32x4*)(SS + (size_t)R * 16); const f32x4 s0 = sp[0], s1 = sp[1], s2 = sp[2], s3 = sp[3];
              const float sq = ((s0[0] + s0[1]) + (s0[2] + s0[3])) + ((s1[0] + s1[1]) + (s1[2] + s1[3])) + ((s2[0] + s2[1]) + (s2[2] + s2[3])) + ((s3[0] + s3[1]) + (s3[2] + s3[3]));
              R2[R] = 1.0f / (sq * (1.0f / 1024.0f) + 1e-6f); } }
        pg8::Gemm g{SEC + 4 * SEC_ELEMS, (const bf16*)(ws + WS_WUP), MQ, FF, DM, 0}; pg8::StaticOrder S; S.init(MQ, FF, F.G, (int)blockIdx.x);
        pg8::EpiUp E{SS, SEC, F.lds + pg8::EPI_STG_OFF};
        pg8::gemm_phase<pg8::EpiUp, pg8::StaticOrder, true, true>(F.lds, g, S, E);
    }
    SEAM(5);
    if (IN(6)) {
        pg8::Gemm g{SEC, (const bf16*)(ws + WS_WDN), MQ, DM, FF, 0}; pg8::StaticOrder S; S.init(MQ, DM, F.G, (int)blockIdx.x);
        pg8::EpiDown E{SEC + 4 * SEC_ELEMS, SEC + 5 * SEC_ELEMS, F.lds + pg8::EPI_STG_OFF, (const float*)(ws + WS_R2)};
        pg8::gemm_phase<pg8::EpiDown, pg8::StaticOrder, true, true>(F.lds, g, S, E);
    }
    SEAM(6);
    if (IN(7)) final_norm(F);
#undef IN
#undef SEAM
}

extern "C" void kernel_launch(void* const* d_in, const int* in_sizes, int n_in, void* d_out, int out_size, void* d_ws, size_t ws_size, hipStream_t stream) {
    static int grid = 0;
    if (grid == 0) {
        if (n_in != 16 || in_sizes[0] != MQ * DM || out_size != MQ * DM || ws_size < WS_END) { fprintf(stderr, "kernel_launch: unexpected shapes (n_in %d in0 %d out %d ws %zu); nothing launched\n", n_in, n_in > 0 ? in_sizes[0] : -1, out_size, ws_size); grid = -1; return; }
        int dev = 0, cus = 0, per_cu = 0;
        (void)hipGetDevice(&dev); (void)hipDeviceGetAttribute(&cus, hipDeviceAttributeMultiprocessorCount, dev);
        if (hipFuncSetAttribute((const void*)mk_fwd, hipFuncAttributeMaxDynamicSharedMemorySize, LDS_BYTES) != hipSuccess) { fprintf(stderr, "kernel_launch: hipFuncSetAttribute failed\n"); grid = -1; return; }
        if (hipOccupancyMaxActiveBlocksPerMultiprocessor(&per_cu, (const void*)mk_fwd, NWAVES * 64, LDS_BYTES) != hipSuccess || per_cu < 1) { fprintf(stderr, "kernel_launch: occupancy query says %d\n", per_cu); per_cu = 1; }
        (void)hipGetLastError();
        grid = cus;
        if (grid <= 0) grid = 256;
    }
    if (grid < 0) return;
    if (hipMemsetAsync((char*)d_ws + WS_BAR, 0, XCD_BAR_WORDS * sizeof(unsigned), stream) != hipSuccess) { fprintf(stderr, "kernel_launch: hipMemsetAsync of the barrier words failed\n"); return; }
    Args a{};
    for (int i = 0; i < 16; ++i) a.in[i] = (const float*)d_in[i];
    a.out = (float*)d_out; a.ws = (unsigned char*)d_ws;
#if MK_MULTI
    for (int p = 0; p < 8; ++p) { a.ph_lo = p; a.ph_hi = p + 1; hipLaunchKernelGGL(mk_fwd, dim3(grid), dim3(NWAVES * 64), LDS_BYTES, stream, a); }
#else
    a.ph_lo = 0; a.ph_hi = 8;
    void* kargs[] = {&a};
    hipError_t e = hipLaunchCooperativeKernel((const void*)mk_fwd, dim3(grid), dim3(NWAVES * 64), kargs, LDS_BYTES, stream);
    if (e != hipSuccess) fprintf(stderr, "kernel_launch: cooperative launch failed: %s (grid %d)\n", hipGetErrorString(e), grid);
#endif
}
```
